# Optimizing an MI355X kernel written in HIP

```python
import numpy as np
import jax
import jax.numpy as jnp
from jax import lax

D_MODEL = 1024
BATCH = 8
SEQ = 4096
DEPTH = 2

CTX_LEN = 256
GRID_W = 64

HEAD_DIM = 64
N_MIXERS = 4
GROUP_W = D_MODEL // N_MIXERS
MIX_HEADS = GROUP_W // HEAD_DIM
D_MIX = N_MIXERS * GROUP_W
D_FF = 2816
N_MOD = 9
ROPE_THETA = 10000.0
EPS = 1e-6
NEG_INF = -1e30

SWA_KV_HEADS = MIX_HEADS // 2
SWA_WINDOW = 128
SWA_BLOCK = 128
DN_CONV = 3
DN_CHUNK = 64
MLA_Q_RANK = D_MODEL // 4
MLA_KV_RANK = D_MODEL // 8
MLA_NOPE = 64
MLA_ROPE = 32
MLA_V = 64
MLA_BLOCK = 128
NA_KR = 8
NA_KC = 16
NA_QC = 16
NA_KSPAN = 2 * NA_QC

IN_SIZES = (GROUP_W, SWA_KV_HEADS * HEAD_DIM, SWA_KV_HEADS * HEAD_DIM,
            3 * GROUP_W, GROUP_W, 2 * MIX_HEADS, 2 * MIX_HEADS,
            MLA_Q_RANK, MLA_KV_RANK, MLA_ROPE,
            GROUP_W, GROUP_W, GROUP_W)
IN_PROJ = sum(IN_SIZES)

kernel_name = 'hybrid_parallel_heads_dit_block'

F32 = jnp.float32


def rms_norm(x, g):
    x32 = x.astype(F32)
    y = x32 * lax.rsqrt(jnp.mean(x32 * x32, axis=-1, keepdims=True) + EPS)
    return (y * g.astype(F32)).astype(x.dtype)


def l2_normalize(x):
    x32 = x.astype(F32)
    return x32 * lax.rsqrt(jnp.sum(x32 * x32, axis=-1, keepdims=True) + EPS)


def modulation(cvec, w, b):
    m = jax.nn.silu(cvec) @ w + b
    m = m.reshape(m.shape[0], 1, N_MOD, D_MODEL)
    return [m[:, :, j] for j in range(N_MOD)]


def pre_norm(h, g, shift, scale):
    return rms_norm(h, g) * (1.0 + scale) + shift


def swiglu(h, wg, wu, wd):
    return (jax.nn.silu(h @ wg) * (h @ wu)) @ wd


def rope_2d(x, row, col):
    half = x.shape[-1] // 2

    def rot(t, pos):
        n = t.shape[-1]
        inv = ROPE_THETA ** (-jnp.arange(0, n, 2, dtype=F32) / n)
        ang = pos[:, None] * inv[None, :]
        cos = jnp.cos(ang)[:, None, :]
        sin = jnp.sin(ang)[:, None, :]
        t1, t2 = jnp.split(t.astype(F32), 2, axis=-1)
        return jnp.concatenate([t1 * cos - t2 * sin, t2 * cos + t1 * sin], axis=-1)

    return jnp.concatenate([rot(x[..., :half], row), rot(x[..., half:], col)], axis=-1).astype(x.dtype)


def joint_softmax(*logits):
    sizes = [l.shape[-1] for l in logits]
    p = jax.nn.softmax(jnp.concatenate([l.astype(F32) for l in logits], axis=-1), axis=-1)
    return jnp.split(p, np.cumsum(sizes)[:-1].tolist(), axis=-1)


def context_attention(q, k, v):
    s = jnp.einsum('bqhd,bkhd->bhqk', q, k).astype(F32)
    p = jax.nn.softmax(s, axis=-1).astype(v.dtype)
    return jnp.einsum('bhqk,bkhd->bqhd', p, v)


def split_in(u):
    return jnp.split(u, np.cumsum(IN_SIZES)[:-1].tolist(), axis=-1)


def swa_mixer(q, k, v, qc, kc, vc, sink, row, col, need_ctx):
    B, S, _ = q.shape
    L = qc.shape[1]
    H, KH, d = MIX_HEADS, SWA_KV_HEADS, HEAD_DIM
    G = H // KH
    scale = d ** -0.5
    q = (rope_2d(q.reshape(B, S, H, d), row, col) * scale).reshape(B, S, KH, G, d)
    k = rope_2d(k.reshape(B, S, KH, d), row, col)
    v = v.reshape(B, S, KH, d)
    kc = kc.reshape(B, L, KH, d)
    vc = vc.reshape(B, L, KH, d)
    sink = sink.astype(F32).reshape(KH, G)
    nb = S // SWA_BLOCK
    span = SWA_BLOCK + 2 * SWA_WINDOW
    idx = np.arange(nb)[:, None] * SWA_BLOCK + np.arange(span)[None, :]
    qpos = np.arange(nb)[:, None] * SWA_BLOCK + np.arange(SWA_BLOCK)[None, :]
    kpos = idx - SWA_WINDOW
    valid = ((np.abs(qpos[:, :, None] - kpos[:, None, :]) <= SWA_WINDOW)
             & (kpos[:, None, :] >= 0) & (kpos[:, None, :] < S))
    pad = ((0, 0), (SWA_WINDOW, SWA_WINDOW), (0, 0), (0, 0))
    kb = jnp.pad(k, pad)[:, idx]
    vb = jnp.pad(v, pad)[:, idx]
    qb = q.reshape(B, nb, SWA_BLOCK, KH, G, d)
    s_loc = jnp.where(valid, jnp.einsum('bnqkgd,bnjkd->bkgnqj', qb, kb).astype(F32), NEG_INF)
    s_ctx = jnp.einsum('bnqkgd,bjkd->bkgnqj', qb, kc)
    s_sink = jnp.broadcast_to(sink[None, :, :, None, None, None], s_ctx.shape[:-1] + (1,))
    p_loc, p_ctx, _ = joint_softmax(s_loc, s_ctx, s_sink)
    o = (jnp.einsum('bkgnqj,bnjkd->bnqkgd', p_loc.astype(v.dtype), vb)
         + jnp.einsum('bkgnqj,bjkd->bnqkgd', p_ctx.astype(v.dtype), vc)).reshape(B, S, GROUP_W)
    if not need_ctx:
        return o, None
    qc = qc.reshape(B, L, KH, G, d) * scale
    sc = jnp.einsum('bqkgd,bjkd->bkgqj', qc, kc)
    sc_sink = jnp.broadcast_to(sink[None, :, :, None, None], sc.shape[:-1] + (1,))
    pc, _ = joint_softmax(sc, sc_sink)
    oc = jnp.einsum('bkgqj,bjkd->bqkgd', pc.astype(vc.dtype), vc).reshape(B, L, GROUP_W)
    return o, oc


def short_conv(x, w):
    C = x.shape[-1]
    p = DN_CONV // 2
    return lax.conv_general_dilated(x, w[:, None, :].astype(x.dtype), window_strides=(1,),
                                    padding=[(p, p)], dimension_numbers=('NWC', 'WIO', 'NWC'),
                                    feature_group_count=C)


def gated_delta_chunked(q, k, v, g, beta, state, with_out):
    B, T, H, dk = q.shape
    dv = v.shape[-1]
    C = DN_CHUNK
    N = T // C

    def blk(t):
        t = t.astype(F32).reshape((B, N, C, H) + t.shape[3:])
        return jnp.moveaxis(t, (1, 3), (0, 2))

    qb, kb, vb, gb, bb = blk(q), blk(k), blk(v), blk(g), blk(beta)
    gc = jnp.cumsum(gb, axis=-1)
    incl = np.tril(np.ones((C, C), dtype=bool))
    strict = np.tril(np.ones((C, C), dtype=bool), -1)
    diff = gc[..., :, None] - gc[..., None, :]
    decay = jnp.where(incl, jnp.exp(jnp.where(incl, diff, 0.0)), 0.0)
    kbeta = kb * bb[..., None]
    a_mat = jnp.where(strict, jnp.einsum('nbhcd,nbhjd->nbhcj', kbeta, kb) * decay, 0.0) + jnp.eye(C, dtype=F32)
    u = lax.linalg.triangular_solve(a_mat, vb * bb[..., None], left_side=True, lower=True, unit_diagonal=True)
    w = lax.linalg.triangular_solve(a_mat, kbeta * jnp.exp(gc)[..., None], left_side=True, lower=True,
                                    unit_diagonal=True)
    xs = (kb, u, w, gc)
    if with_out:
        intra = jnp.einsum('nbhcd,nbhjd->nbhcj', qb, kb) * decay
        xs = xs + (qb, intra)

    def step(s, xs_n):
        k_n, u_n, w_n, g_n = xs_n[:4]
        v_new = u_n - jnp.einsum('bhcd,bhde->bhce', w_n, s)
        g_last = g_n[..., -1]
        s_next = (s * jnp.exp(g_last)[..., None, None]
                  + jnp.einsum('bhcd,bhce->bhde', k_n * jnp.exp(g_last[..., None] - g_n)[..., None], v_new))
        if with_out:
            q_n, a_n = xs_n[4:]
            o = (jnp.einsum('bhcd,bhde->bhce', q_n * jnp.exp(g_n)[..., None], s)
                 + jnp.einsum('bhcj,bhje->bhce', a_n, v_new))
            return s_next, o
        return s_next, None

    s_fin, o = lax.scan(step, state.astype(F32), xs)
    if with_out:
        o = jnp.moveaxis(o, (0, 2), (1, 3)).reshape(B, T, H, dv)
    return o, s_fin


def deltanet_mixer(qkv, z, a, b, qkv_c, z_c, a_c, b_c, conv_w, a_log, dt_bias, norm_g, need_ctx):
    H, d = MIX_HEADS, HEAD_DIM

    def prep(qkv_t, a_t, b_t):
        B, T, _ = qkv_t.shape
        h = jax.nn.silu(short_conv(qkv_t, conv_w))
        q_t, k_t, v_t = jnp.split(h, 3, axis=-1)
        q_t = l2_normalize(q_t.reshape(B, T, H, d)) * (d ** -0.5)
        k_t = l2_normalize(k_t.reshape(B, T, H, d))
        v_t = v_t.reshape(B, T, H, d).astype(F32)
        g_t = -jnp.exp(a_log.astype(F32)) * jax.nn.softplus(a_t.reshape(B, T, 2, H).astype(F32)
                                                            + dt_bias.astype(F32))
        beta_t = jax.nn.sigmoid(b_t.reshape(B, T, 2, H).astype(F32))
        return q_t, k_t, v_t, g_t, beta_t

    def gated_out(o, z_t):
        B, T = z_t.shape[:2]
        y = rms_norm(o, norm_g) * jax.nn.silu(z_t.reshape(B, T, H, d).astype(F32))
        return y.reshape(B, T, GROUP_W).astype(z_t.dtype)

    def rev(t):
        return jnp.flip(t, axis=1)

    qc, kc, vc, gcx, bcx = prep(qkv_c, a_c, b_c)
    ql, kl, vl, gl, bl = prep(qkv, a, b)
    s0 = jnp.zeros((qkv.shape[0], H, d, d), F32)
    oc_f, s_f = gated_delta_chunked(qc, kc, vc, gcx[:, :, 0], bcx[:, :, 0], s0, need_ctx)
    oc_b, s_b = gated_delta_chunked(rev(qc), rev(kc), rev(vc), rev(gcx[:, :, 1]), rev(bcx[:, :, 1]), s0, need_ctx)
    ol_f, _ = gated_delta_chunked(ql, kl, vl, gl[:, :, 0], bl[:, :, 0], s_f, True)
    ol_b, _ = gated_delta_chunked(rev(ql), rev(kl), rev(vl), rev(gl[:, :, 1]), rev(bl[:, :, 1]), s_b, True)
    y = gated_out(ol_f + rev(ol_b), z)
    if not need_ctx:
        return y, None
    return y, gated_out(oc_f + rev(oc_b), z_c)


def mla_mixer(cq, ckv, kr, cq_c, ckv_c, kr_c, q_norm_g, w_uq, kv_norm_g, w_ukv, row, col, need_ctx):
    H = MIX_HEADS
    dqk = MLA_NOPE + MLA_ROPE
    scale = dqk ** -0.5

    def heads(cq_t, ckv_t, kr_t, rotary):
        B, T, _ = cq_t.shape
        q_t = (rms_norm(cq_t, q_norm_g) @ w_uq).reshape(B, T, H, dqk)
        kv = (rms_norm(ckv_t, kv_norm_g) @ w_ukv).reshape(B, T, H, MLA_NOPE + MLA_V)
        q_nope, q_rope = q_t[..., :MLA_NOPE], q_t[..., MLA_NOPE:]
        k_nope, v_t = kv[..., :MLA_NOPE], kv[..., MLA_NOPE:]
        k_rope = kr_t.reshape(B, T, 1, MLA_ROPE)
        if rotary:
            q_rope = rope_2d(q_rope, row, col)
            k_rope = rope_2d(k_rope, row, col)
        q_t = jnp.concatenate([q_nope, q_rope], axis=-1) * scale
        k_t = jnp.concatenate([k_nope, jnp.broadcast_to(k_rope, (B, T, H, MLA_ROPE))], axis=-1)
        return q_t, k_t, v_t

    q, k, v = heads(cq, ckv, kr, True)
    qc, kc, vc = heads(cq_c, ckv_c, kr_c, False)
    B, S = q.shape[:2]
    k_all = jnp.concatenate([kc, k], axis=1)
    v_all = jnp.concatenate([vc, v], axis=1)
    nb = S // MLA_BLOCK

    def block(qi):
        s = jnp.einsum('bqhd,bkhd->bhqk', qi, k_all).astype(F32)
        p = jax.nn.softmax(s, axis=-1).astype(v_all.dtype)
        return jnp.einsum('bhqk,bkhd->bqhd', p, v_all)

    qb = jnp.moveaxis(q.reshape(B, nb, MLA_BLOCK, H, dqk), 1, 0)
    o = jnp.moveaxis(lax.map(block, qb), 0, 1).reshape(B, S, H * MLA_V)
    if not need_ctx:
        return o, None
    oc = context_attention(qc, kc, vc).reshape(B, qc.shape[1], H * MLA_V)
    return o, oc


def na_mixer(q, k, v, qc, kc, vc, rpb, need_ctx):
    B, S, _ = q.shape
    L = qc.shape[1]
    H, d, W = MIX_HEADS, HEAD_DIM, GRID_W
    rows = S // W
    kr = min(NA_KR, rows)
    scale = d ** -0.5
    qg = q.reshape(B, rows, W, H, d) * scale
    kg = k.reshape(B, rows, W, H, d)
    vg = v.reshape(B, rows, W, H, d)
    kc = kc.reshape(B, L, H, d)
    vc = vc.reshape(B, L, H, d)
    ncb = W // NA_QC
    col_start = np.clip(np.arange(ncb) * NA_QC - NA_KC // 2, 0, W - NA_KSPAN)
    kcol = col_start[:, None] + np.arange(NA_KSPAN)[None, :]
    qcol = np.arange(ncb)[:, None] * NA_QC + np.arange(NA_QC)[None, :]
    cs = np.clip(qcol - NA_KC // 2, 0, W - NA_KC)
    col_ok = (kcol[:, None, :] >= cs[:, :, None]) & (kcol[:, None, :] < cs[:, :, None] + NA_KC)
    dc_idx = np.clip(kcol[:, None, :] - qcol[:, :, None] + NA_KC - 1, 0, 2 * NA_KC - 2)

    def row_block(args):
        r, q_row = args
        rs = jnp.clip(r - kr // 2, 0, rows - kr)
        k_rows = lax.dynamic_slice_in_dim(kg, rs, kr, axis=1)[:, :, kcol]
        v_rows = lax.dynamic_slice_in_dim(vg, rs, kr, axis=1)[:, :, kcol]
        qb = q_row.reshape(B, ncb, NA_QC, H, d)
        dr_idx = rs + jnp.arange(kr) - r + NA_KR - 1
        bias = rpb[:, dr_idx[:, None, None, None], dc_idx[None]]
        s_loc = (jnp.einsum('bnqhd,brnkhd->bhnqrk', qb, k_rows).astype(F32)
                 + jnp.transpose(bias, (0, 2, 3, 1, 4)).astype(F32))
        s_loc = jnp.where(col_ok[:, :, None, :], s_loc, NEG_INF).reshape(B, H, ncb, NA_QC, kr * NA_KSPAN)
        s_ctx = jnp.einsum('bnqhd,bkhd->bhnqk', qb, kc)
        p_loc, p_ctx = joint_softmax(s_loc, s_ctx)
        p_loc = p_loc.reshape(B, H, ncb, NA_QC, kr, NA_KSPAN).astype(v_rows.dtype)
        o = (jnp.einsum('bhnqrk,brnkhd->bnqhd', p_loc, v_rows)
             + jnp.einsum('bhnqk,bkhd->bnqhd', p_ctx.astype(vc.dtype), vc))
        return o.reshape(B, W, H * d)

    o = lax.map(row_block, (jnp.arange(rows), jnp.moveaxis(qg, 1, 0)))
    o = jnp.moveaxis(o, 0, 1).reshape(B, S, GROUP_W)
    if not need_ctx:
        return o, None
    oc = context_attention(qc.reshape(B, L, H, d) * scale, kc, vc).reshape(B, L, GROUP_W)
    return o, oc


def setup_inputs(seed: int = 0) -> dict:
    key = jax.random.key(seed)
    ks = iter(jax.random.split(key, 32))
    L, D = DEPTH, D_MODEL

    def nrm(shape, std):
        return std * jax.random.normal(next(ks), shape, F32)

    def gain(shape):
        return 1.0 + nrm(shape, 0.02)

    dt = jnp.exp(jax.random.uniform(next(ks), (L, 2, MIX_HEADS), F32, float(np.log(1e-3)), float(np.log(1e-1))))
    return {
        'x': nrm((BATCH, SEQ, D), 1.0),
        'c': nrm((BATCH, D), 1.0),
        'ctx': nrm((BATCH, CTX_LEN, D), 1.0),
        'c_ctx': nrm((D,), 1.0),
        'ada_w': nrm((L, D, N_MOD * D), 0.5 * D ** -0.5),
        'ada_b': nrm((L, N_MOD * D), 0.01),
        'norm1_g': gain((L, D)),
        'ffn1_wg': nrm((L, D, D_FF), D ** -0.5),
        'ffn1_wu': nrm((L, D, D_FF), D ** -0.5),
        'ffn1_wd': nrm((L, D_FF, D), D_FF ** -0.5),
        'norm2_g': gain((L, D)),
        'w_in': nrm((L, D, IN_PROJ), D ** -0.5),
        'swa_sink': nrm((L, MIX_HEADS), 0.5),
        'dn_conv_w': nrm((L, DN_CONV, 3 * GROUP_W), DN_CONV ** -0.5),
        'dn_a_log': jnp.log(jax.random.uniform(next(ks), (L, 2, MIX_HEADS), F32, 1.0, 16.0)),
        'dn_dt_bias': dt + jnp.log(-jnp.expm1(-dt)),
        'dn_norm_g': gain((L, HEAD_DIM)),
        'mla_q_norm_g': gain((L, MLA_Q_RANK)),
        'mla_w_uq': nrm((L, MLA_Q_RANK, MIX_HEADS * (MLA_NOPE + MLA_ROPE)), MLA_Q_RANK ** -0.5),
        'mla_kv_norm_g': gain((L, MLA_KV_RANK)),
        'mla_w_ukv': nrm((L, MLA_KV_RANK, MIX_HEADS * (MLA_NOPE + MLA_V)), MLA_KV_RANK ** -0.5),
        'na_rpb': nrm((L, MIX_HEADS, 2 * NA_KR - 1, 2 * NA_KC - 1), 0.1),
        'w_out': nrm((L, D_MIX, D), D_MIX ** -0.5),
        'norm3_g': gain((L, D)),
        'ffn2_wg': nrm((L, D, D_FF), D ** -0.5),
        'ffn2_wu': nrm((L, D, D_FF), D ** -0.5),
        'ffn2_wd': nrm((L, D_FF, D), D_FF ** -0.5),
        'final_norm_g': gain((D,)),
    }


def reference(x, c, ctx, c_ctx, ada_w, ada_b, norm1_g, ffn1_wg, ffn1_wu, ffn1_wd, norm2_g, w_in,
              swa_sink, dn_conv_w, dn_a_log, dn_dt_bias, dn_norm_g, mla_q_norm_g, mla_w_uq,
              mla_kv_norm_g, mla_w_ukv, na_rpb, w_out, norm3_g, ffn2_wg, ffn2_wu, ffn2_wd, final_norm_g):
    S = x.shape[1]
    t = jnp.arange(S)
    row = (t // GRID_W).astype(F32)
    col = (t % GRID_W).astype(F32)
    xc = ctx
    for i in range(DEPTH):
        need_ctx = i < DEPTH - 1
        mx = modulation(c, ada_w[i], ada_b[i])
        mc = modulation(c_ctx[None, :], ada_w[i], ada_b[i])
        x = x + 0.5 * mx[2] * swiglu(pre_norm(x, norm1_g[i], mx[0], mx[1]), ffn1_wg[i], ffn1_wu[i], ffn1_wd[i])
        xc = xc + 0.5 * mc[2] * swiglu(pre_norm(xc, norm1_g[i], mc[0], mc[1]), ffn1_wg[i], ffn1_wu[i], ffn1_wd[i])
        ux = split_in(pre_norm(x, norm2_g[i], mx[3], mx[4]) @ w_in[i])
        uc = split_in(pre_norm(xc, norm2_g[i], mc[3], mc[4]) @ w_in[i])
        ya, yac = swa_mixer(ux[0], ux[1], ux[2], uc[0], uc[1], uc[2], swa_sink[i], row, col, need_ctx)
        yd, ydc = deltanet_mixer(ux[3], ux[4], ux[5], ux[6], uc[3], uc[4], uc[5], uc[6], dn_conv_w[i],
                                 dn_a_log[i], dn_dt_bias[i], dn_norm_g[i], need_ctx)
        ym, ymc = mla_mixer(ux[7], ux[8], ux[9], uc[7], uc[8], uc[9], mla_q_norm_g[i], mla_w_uq[i],
                            mla_kv_norm_g[i], mla_w_ukv[i], row, col, need_ctx)
        yn, ync = na_mixer(ux[10], ux[11], ux[12], uc[10], uc[11], uc[12], na_rpb[i], need_ctx)
        x = x + mx[5] * (jnp.concatenate([ya, yd, ym, yn], axis=-1) @ w_out[i])
        x = x + 0.5 * mx[8] * swiglu(pre_norm(x, norm3_g[i], mx[6], mx[7]), ffn2_wg[i], ffn2_wu[i], ffn2_wd[i])
        if need_ctx:
            xc = xc + mc[5] * (jnp.concatenate([yac, ydc, ymc, ync], axis=-1) @ w_out[i])
            xc = xc + 0.5 * mc[8] * swiglu(pre_norm(xc, norm3_g[i], mc[6], mc[7]), ffn2_wg[i], ffn2_wu[i],
                                           ffn2_wd[i])
    return rms_norm(x, final_norm_g)
```

```cpp
#include <hip/hip_runtime.h>
#include <hip/hip_cooperative_groups.h>
#include <cstdint>
#include <cstring>
#include <cstdio>
namespace cg = cooperative_groups;

typedef unsigned short bf16_t;
typedef short bf16x8 __attribute__((ext_vector_type(8)));
typedef short s16x4 __attribute__((ext_vector_type(4)));
typedef float f32x4 __attribute__((ext_vector_type(4)));
typedef unsigned u32x4 __attribute__((ext_vector_type(4)));

__device__ __forceinline__ int raw_tid() { int t = threadIdx.x; asm volatile("" : "+v"(t)); return t; }
#define NLAT 32768
#define NCTX 2048
#define NTOK 34816
#define DM 1024
#define DFF 2816
#define UW 2048
#define EPSF 1e-6f
#define LDS_BYTES 53248

struct Params {
  const float *x, *c, *ctx, *c_ctx, *ada_w, *ada_b, *norm1_g, *ffn1_wg, *ffn1_wu, *ffn1_wd, *norm2_g, *w_in,
      *swa_sink, *dn_conv_w, *dn_a_log, *dn_dt_bias, *dn_norm_g, *mla_q_norm_g, *mla_w_uq, *mla_kv_norm_g,
      *mla_w_ukv, *na_rpb, *w_out, *norm3_g, *ffn2_wg, *ffn2_wu, *ffn2_wd, *final_norm_g;
  float* out;
  float* Xc; bf16_t* XN; bf16_t* W; float* MOD; unsigned* cnt; unsigned* bar; unsigned* kmx;
  bf16_t* H; bf16_t* U; bf16_t* QM; bf16_t* KVM; bf16_t* QKVd; bf16_t* QKVraw; bf16_t* DNW; bf16_t* DNU; bf16_t* DNI;
  float* DGC; bf16_t* OF; bf16_t* OB; float* GB; float* PART;
};

#define OW_GU1 0
#define OW_D1 5767168
#define OW_IN 8650752
#define OW_UQ 11534336
#define OW_UKV 11632640
#define OW_OUT 11698176
#define OW_GU2 12746752
#define OW_D2 18513920
#define W_ELEMS 21397504

__device__ __forceinline__ bf16_t f2bf(float f) { unsigned u = __float_as_uint(f); u += 0x7fffu + ((u >> 16) & 1u); return (bf16_t)(u >> 16); }
__device__ __forceinline__ float bf2f(bf16_t h) { return __uint_as_float(((unsigned)h) << 16); }
typedef unsigned u32x2 __attribute__((ext_vector_type(2)));
typedef float f32x2 __attribute__((ext_vector_type(2)));
typedef __bf16 bf16x2_t __attribute__((ext_vector_type(2)));
__device__ __forceinline__ unsigned cvt_pk_bf16(float lo, float hi) { const f32x2 v = {lo, hi}; return __builtin_bit_cast(unsigned, __builtin_convertvector(v, bf16x2_t)); }
__device__ __forceinline__ s16x4 pack4(float a, float b, float c, float d) { u32x2 r; r[0] = cvt_pk_bf16(a, b); r[1] = cvt_pk_bf16(c, d); return __builtin_bit_cast(s16x4, r); }
__device__ __forceinline__ float siluf(float v) { return v * __builtin_amdgcn_rcpf(1.f + __expf(-v)); }
__device__ __forceinline__ float wave_sum(float v) {
#pragma unroll
  for (int o = 32; o >= 1; o >>= 1) v += __shfl_xor(v, o);
  return v;
}
__device__ __forceinline__ int vb_() { int v = __builtin_amdgcn_readfirstlane((int)(blockIdx.x * 2 + (raw_tid() >> 8))); asm volatile("" : "+s"(v)); return v; }
__device__ __forceinline__ int nvb_() { int v = (int)(gridDim.x * 2); asm volatile("" : "+s"(v)); return v; }
#define VB vb_()
#define NVB nvb_()
__device__ __forceinline__ int opaque_tid() { return raw_tid() & 255; }
#define MFMA(a, b, c) __builtin_amdgcn_mfma_f32_16x16x32_bf16((a), (b), (c), 0, 0, 0)


#define XB_TMO      128
#define XB_XCNT(j)  (256  + 64 * (j))
#define XB_XSUB(j)  (1280 + 64 * (j))
#define XB_XGEN(j)  (2304 + 64 * (j))
#define XB_TOP      3328
#define XB_TOPGEN   3392
#define XCD_BAR_WORDS 3456
#define XB_SPIN_CAP (1u << 22)
#define LAS __attribute__((address_space(3)))
__device__ __forceinline__ unsigned xb_ld(unsigned* p)              { return __hip_atomic_load(p, __ATOMIC_RELAXED, __HIP_MEMORY_SCOPE_AGENT); }
__device__ __forceinline__ unsigned xb_add(unsigned* p, unsigned v) { return __hip_atomic_fetch_add(p, v, __ATOMIC_RELAXED, __HIP_MEMORY_SCOPE_AGENT); }
__device__ __forceinline__ unsigned xb_xcc_id() { return (unsigned)__builtin_amdgcn_s_getreg((3 << 11) | 20) & 0xFu; }
#define XB_SPIN(cond, bar) do { unsigned _sp = 0; while (cond) { __builtin_amdgcn_s_sleep(1); \
    if ((++_sp & 255u) == 0u) { if (xb_ld(&(bar)[XB_TMO])) break; if (_sp > XB_SPIN_CAP) { atomicAdd(&(bar)[XB_TMO], 1u); break; } } } } while (0)
struct XcdBarrier { unsigned* bar; unsigned x; volatile LAS unsigned* st; };
__device__ __forceinline__ XcdBarrier xcd_barrier_post(unsigned* bar, volatile LAS unsigned* st) {
    XcdBarrier b; b.bar = bar; b.x = xb_xcc_id(); b.st = st;
    if (raw_tid() == 0) (void)xb_add(&bar[XB_XCNT(b.x)], 1u);
    return b;
}
__device__ __forceinline__ void xcd_barrier_complete(unsigned* bar, unsigned x, unsigned& nloc, unsigned& nx) {
    const unsigned G = gridDim.x * gridDim.y * gridDim.z;
    unsigned sum, cnt, mine, sp = 0u;
    for (;;) {
        sum = 0u; cnt = 0u; mine = 0u;
#pragma unroll
        for (unsigned j = 0; j < 16; ++j) { const unsigned c = xb_ld(&bar[XB_XCNT(j)]); sum += c; cnt += (c > 0u) ? 1u : 0u; mine = (j == x) ? c : mine; }
        if (sum == G) break;
        __builtin_amdgcn_s_sleep(1);
        if ((++sp & 255u) == 0u) { if (xb_ld(&bar[XB_TMO])) break; if (sp > XB_SPIN_CAP) { atomicAdd(&bar[XB_TMO], 1u); break; } }
    }
    nloc = mine > 0u ? mine : 1u; nx = cnt > 0u ? cnt : 1u;
}
__device__ __forceinline__ void xcd_barrier(const XcdBarrier& b) {
    asm volatile("s_waitcnt vmcnt(0)" ::: "memory");
    __syncthreads();
    if (raw_tid() == 0) {
        unsigned* bar = b.bar; const unsigned bx = xb_xcc_id();
        __builtin_amdgcn_s_waitcnt(0);
        unsigned nloc = b.st[0], nx = b.st[1];
        if (nloc == 0u) { xcd_barrier_complete(bar, bx, nloc, nx); b.st[0] = nloc; b.st[1] = nx; }
        const unsigned old = xb_add(&bar[XB_XSUB(bx)], 1u);
        const unsigned gen = old / nloc;
        if (old + 1u == (gen + 1u) * nloc) {
            __builtin_amdgcn_fence(__ATOMIC_RELEASE, "agent");
            asm volatile("s_waitcnt vmcnt(0)" ::: "memory");
            const unsigned og = xb_add(&bar[XB_TOP], 1u);
            const unsigned tg = og / nx;
            if (og + 1u == (tg + 1u) * nx) xb_add(&bar[XB_TOPGEN], 1u);
            else XB_SPIN(xb_ld(&bar[XB_TOPGEN]) == tg, bar);
            __builtin_amdgcn_fence(__ATOMIC_ACQUIRE, "agent");
            xb_add(&bar[XB_XGEN(bx)], 1u);
            asm volatile("s_waitcnt vmcnt(0)" ::: "memory");
        } else {
            XB_SPIN(xb_ld(&bar[XB_XGEN(bx)]) == gen, bar);
            __builtin_amdgcn_fence(__ATOMIC_ACQUIRE, "agent");
            asm volatile("s_waitcnt vmcnt(0)" ::: "memory");
        }
    }
    __syncthreads();
}

__device__ __forceinline__ void conv_job(const float* __restrict__ src, int K, int N, bf16_t* __restrict__ dst, int ldd, int map, float* tl) {
  const int tid = opaque_tid();
  const int ntn = (N + 63) / 64, nt = (K / 64) * ntn;
  for (int t0 = VB; t0 < nt; t0 += NVB * 2) {
    __syncthreads();
    f32x4 v[2][4];
#pragma unroll
    for (int u = 0; u < 2; ++u) { const int t = t0 + u * NVB; const int k0 = (t / ntn) * 64, n0 = (t % ntn) * 64;
#pragma unroll
      for (int i = 0; i < 4; ++i) { const int id = tid + 256 * i, kk = id >> 4, n4 = (id & 15) * 4;
        v[u][i] = (f32x4){0.f, 0.f, 0.f, 0.f};
        if (t < nt && n0 + n4 < N) v[u][i] = *(const f32x4*)(src + (size_t)(k0 + kk) * N + n0 + n4); } }
#pragma unroll
    for (int u = 0; u < 2; ++u)
#pragma unroll
      for (int i = 0; i < 4; ++i) { const int id = tid + 256 * i, kk = id >> 4, n4 = (id & 15) * 4; float* tp = tl + u * 4160 + kk * 65 + n4;
        tp[0] = v[u][i][0]; tp[1] = v[u][i][1]; tp[2] = v[u][i][2]; tp[3] = v[u][i][3]; }
    __syncthreads();
#pragma unroll
    for (int u = 0; u < 2; ++u) { const int t = t0 + u * NVB; if (t >= nt) continue; const int k0 = (t / ntn) * 64, n0 = (t % ntn) * 64;
#pragma unroll
      for (int i = 0; i < 2; ++i) {
        const int id = tid + 256 * i, nn = id >> 3, kc = id & 7, n = n0 + nn;
        if (n < N) {
          int dr = n; if (map == 1) dr = (n >> 4) * 32 + (n & 15); else if (map == 2) dr = (n >> 4) * 32 + 16 + (n & 15);
          u32x4 o; const float* tp = tl + u * 4160;
#pragma unroll
          for (int e = 0; e < 4; ++e) o[e] = cvt_pk_bf16(tp[(kc * 8 + 2 * e) * 65 + nn], tp[(kc * 8 + 2 * e + 1) * 65 + nn]);
          *(u32x4*)(dst + (size_t)dr * ldd + k0 + kc * 8) = o;
        }
      } }
  }
}
__device__ __forceinline__ void conv_weights(const Params& p, int l, float* tl) {
  const size_t ff = (size_t)DM * DFF;
  conv_job(p.ffn1_wg + l * ff, DM, DFF, p.W + OW_GU1, DM, 1, tl);
  conv_job(p.ffn1_wu + l * ff, DM, DFF, p.W + OW_GU1, DM, 2, tl);
  conv_job(p.ffn1_wd + l * ff, DFF, DM, p.W + OW_D1, DFF, 0, tl);
  conv_job(p.w_in + (size_t)l * DM * 2736, DM, 2736, p.W + OW_IN, DM, 0, tl);
  conv_job(p.mla_w_uq + (size_t)l * 256 * 384, 256, 384, p.W + OW_UQ, 256, 0, tl);
  conv_job(p.mla_w_ukv + (size_t)l * 128 * 512, 128, 512, p.W + OW_UKV, 128, 0, tl);
  conv_job(p.w_out + (size_t)l * DM * DM, DM, DM, p.W + OW_OUT, DM, 0, tl);
  conv_job(p.ffn2_wg + l * ff, DM, DFF, p.W + OW_GU2, DM, 1, tl);
  conv_job(p.ffn2_wu + l * ff, DM, DFF, p.W + OW_GU2, DM, 2, tl);
  conv_job(p.ffn2_wd + l * ff, DFF, DM, p.W + OW_D2, DFF, 0, tl);
  for (int e = VB * 256 + opaque_tid(); e < 80 * DM; e += NVB * 256) p.W[OW_IN + (size_t)2736 * DM + e] = 0;
}

__device__ __forceinline__ void mod_partial(const Params& p, float* sl) {
  const int tid = opaque_tid();
  for (int it = VB; it < 504; it += NVB) {
    const int kc = it % 7, cb = (it / 7) % 36, l = it / 252;
    const int kbeg = kc == 6 ? 877 : kc * 147, kskip = kc == 6 ? 5 : 0;
    __syncthreads();
    for (int e = tid; e < 9 * 147; e += 256) { const int r = e / 147, kk = e - r * 147;
      const float v = r < 8 ? p.c[r * 1024 + kbeg + kk] : p.c_ctx[kbeg + kk]; sl[e] = kk < kskip ? 0.f : v / (1.f + expf(-v)); }
    __syncthreads();
    const int j = cb * 256 + tid;
    const float* w = p.ada_w + (size_t)l * 1024 * 9216 + (size_t)kbeg * 9216 + j;
    float acc[9];
#pragma unroll
    for (int r = 0; r < 9; ++r) acc[r] = 0.f;
#pragma unroll 16
    for (int kk = 0; kk < 147; ++kk) {
      float wv = w[(size_t)kk * 9216];
#pragma unroll
      for (int r = 0; r < 9; ++r) acc[r] += sl[r * 147 + kk] * wv;
    }
#pragma unroll
    for (int r = 0; r < 9; ++r) p.PART[(size_t)kc * 165888 + (size_t)(l * 9 + r) * 9216 + j] = acc[r];
  }
}
__device__ __forceinline__ void mod_final(const Params& p) {
  for (int e = VB * 256 + opaque_tid(); e < 165888; e += NVB * 256) {
    int l = e / 82944, j = e % 9216;
    float s = p.ada_b[l * 9216 + j];
#pragma unroll
    for (int kc = 0; kc < 7; ++kc) s += p.PART[(size_t)kc * 165888 + e];
    p.MOD[e] = s;
  }
}

template <int MODE, int R>
__device__ __forceinline__ void norm_rows(int row0, int lane, const float* srcL, const float* srcC, const float* g, const float* mod, int shift_i, int scale_i, bf16_t* XN, float* outp) {
  f32x4 v[R][4]; float ss[R];
#pragma unroll
  for (int k = 0; k < R; ++k) {
    const int row = row0 + k;
    const float* src = row < NLAT ? srcL + (size_t)row * DM : srcC + (size_t)(row - NLAT) * DM;
#pragma unroll
    for (int i = 0; i < 4; ++i) v[k][i] = *(const f32x4*)(src + i * 256 + lane * 4);
  }
#pragma unroll
  for (int k = 0; k < R; ++k) { float a = 0.f;
#pragma unroll
    for (int i = 0; i < 4; ++i) a += v[k][i][0] * v[k][i][0] + v[k][i][1] * v[k][i][1] + v[k][i][2] * v[k][i][2] + v[k][i][3] * v[k][i][3];
    ss[k] = wave_sum(a); }
#pragma unroll
  for (int k = 0; k < R; ++k) {
    const int row = row0 + k;
    const float rs = rsqrtf(ss[k] * (1.f / 1024.f) + EPSF);
    const int mr = row < NLAT ? (row >> 12) : 8;
#pragma unroll
    for (int i = 0; i < 4; ++i) {
      const int col = i * 256 + lane * 4;
      const f32x4 gg = *(const f32x4*)(g + col);
      if (MODE == 0) {
        const f32x4 sc = *(const f32x4*)(mod + mr * 9216 + scale_i * 1024 + col);
        const f32x4 sh = *(const f32x4*)(mod + mr * 9216 + shift_i * 1024 + col);
        f32x4 y = (v[k][i] * rs * gg) * (sc + 1.f) + sh;
        *(s16x4*)(XN + (size_t)row * DM + col) = pack4(y[0], y[1], y[2], y[3]);
      } else {
        *(f32x4*)(outp + (size_t)row * DM + col) = v[k][i] * rs * gg;
      }
    }
  }
}
template <int MODE>
__device__ __forceinline__ void norm_phase(const float* srcL, const float* srcC, int M, const float* g, const float* mod, int shift_i, int scale_i, bf16_t* XN, float* outp) {
  const int tid = opaque_tid(); const int lane = tid & 63, w = tid >> 6;
  const int gw = VB * 4 + w, NW = NVB * 4;
  int base = 0;
  if (M == NTOK) { norm_rows<MODE, 5>(gw * 5, lane, srcL, srcC, g, mod, shift_i, scale_i, XN, outp); base = NW * 5; }
  for (; base < M; base += NW * 4) norm_rows<MODE, 4>(base + gw * 4, lane, srcL, srcC, g, mod, shift_i, scale_i, XN, outp);
}

struct EpiGU {
  bf16_t* H;
  __device__ __forceinline__ void operator()(const f32x4 (&acc)[4][4], int row0, int col0, int r, int gq) const {
    const int hb = col0 >> 1;
#pragma unroll
    for (int m = 0; m < 4; ++m) {
      const size_t row = row0 + m * 16 + r;
#pragma unroll
      for (int pz = 0; pz < 2; ++pz) {
        const f32x4 gt = acc[m][2 * pz], up = acc[m][2 * pz + 1];
        *(s16x4*)(H + row * DFF + hb + pz * 16 + 4 * gq) = pack4(siluf(gt[0]) * up[0], siluf(gt[1]) * up[1], siluf(gt[2]) * up[2], siluf(gt[3]) * up[3]);
      }
    }
  }
};
struct EpiResid {
  const float* srcL; const float* srcC; float* dstL; float* dstC; const float* mod; int gi; float fac;
  __device__ __forceinline__ void operator()(const f32x4 (&acc)[4][4], int row0, int col0, int r, int gq) const {
#pragma unroll
    for (int m = 0; m < 4; ++m) {
      const int row = row0 + m * 16 + r;
      const float* sp = row < NLAT ? srcL + (size_t)row * DM : srcC + (size_t)(row - NLAT) * DM;
      float* dp = row < NLAT ? dstL + (size_t)row * DM : dstC + (size_t)(row - NLAT) * DM;
      const float* mp = mod + (row < NLAT ? (row >> 12) : 8) * 9216 + gi * 1024;
#pragma unroll
      for (int n = 0; n < 4; ++n) {
        const int col = col0 + n * 16 + 4 * gq;
        const f32x4 gt = *(const f32x4*)(mp + col);
        const f32x4 s = *(const f32x4*)(sp + col);
        *(f32x4*)(dp + col) = s + (gt * fac) * acc[m][n];
      }
    }
  }
};
struct EpiInproj {
  bf16_t* U; bf16_t* QKVraw;
  __device__ __forceinline__ void operator()(const f32x4 (&acc)[4][4], int row0, int col0, int r, int gq) const {
    bf16_t* base; int ld, cb;
    if (col0 < 512) { base = U; ld = UW; cb = col0; }
    else if (col0 < 1280) { base = QKVraw; ld = 768; cb = col0 - 512; }
    else { base = U; ld = UW; cb = col0 - 768; }
#pragma unroll
    for (int m = 0; m < 4; ++m) {
      const size_t row = row0 + m * 16 + r;
#pragma unroll
      for (int n = 0; n < 4; ++n) *(s16x4*)(base + row * ld + cb + n * 16 + 4 * gq) = pack4(acc[m][n][0], acc[m][n][1], acc[m][n][2], acc[m][n][3]);
    }
  }
};
struct EpiKVM {
  bf16_t* C; unsigned* kn2;
  __device__ __forceinline__ void operator()(const f32x4 (&acc)[4][4], int row0, int col0, int r, int gq) const {
    const bool nope = (col0 & 64) == 0;
    float rmax = 0.f;
#pragma unroll
    for (int m = 0; m < 4; ++m) {
      const size_t row = row0 + m * 16 + r; float ss = 0.f;
#pragma unroll
      for (int n = 0; n < 4; ++n) {
        const s16x4 pk = pack4(acc[m][n][0], acc[m][n][1], acc[m][n][2], acc[m][n][3]);
        *(s16x4*)(C + row * 512 + col0 + n * 16 + 4 * gq) = pk;
#pragma unroll
        for (int j = 0; j < 4; ++j) { const float v = __uint_as_float(((unsigned)(unsigned short)pk[j]) << 16); ss += v * v; }
      }
      ss += __shfl_xor(ss, 16); ss += __shfl_xor(ss, 32);
      rmax = fmaxf(rmax, ss);
    }
    if (nope) {
#pragma unroll
      for (int o = 1; o < 16; o <<= 1) rmax = fmaxf(rmax, __shfl_xor(rmax, o));
      const int b = row0 < NLAT ? (row0 >> 12) : ((row0 - NLAT) >> 8);
      if (r == 0 && gq == 0) __hip_atomic_fetch_max(kn2 + b * 4 + (col0 >> 7), __float_as_uint(rmax), __ATOMIC_RELAXED, __HIP_MEMORY_SCOPE_AGENT);
    }
  }
};
struct EpiPlain {
  bf16_t* C; int ldc;
  __device__ __forceinline__ void operator()(const f32x4 (&acc)[4][4], int row0, int col0, int r, int gq) const {
#pragma unroll
    for (int m = 0; m < 4; ++m) {
      const size_t row = row0 + m * 16 + r;
#pragma unroll
      for (int n = 0; n < 4; ++n) *(s16x4*)(C + row * ldc + col0 + n * 16 + 4 * gq) = pack4(acc[m][n][0], acc[m][n][1], acc[m][n][2], acc[m][n][3]);
    }
  }
};

template <class Epi>
__device__ __forceinline__ void gemm_phase(const bf16_t* __restrict__ A, int lda, const bf16_t* __restrict__ Bt, int ldb, int M, int N, int K, const Epi& epi, unsigned char* lds) {
  bf16_t* As = (bf16_t*)lds; bf16_t* Bs = As + 128 * 72;
  const int tid = opaque_tid(), lane = tid & 63, w = tid >> 6, wr = w >> 1, wc = w & 1, r = lane & 15, gq = lane >> 4;
  const int ntn = N / 128, nt = (M / 128) * ntn, nk = K / 64;
  for (int tile = VB; tile < nt; tile += NVB) {
    const int pm = tile / ntn, pn = tile - pm * ntn;
    const bf16_t* Ag = A + (size_t)(pm * 128) * lda; const bf16_t* Bg = Bt + (size_t)(pn * 128) * ldb;
    f32x4 acc[4][4];
#pragma unroll
    for (int m = 0; m < 4; ++m)
#pragma unroll
      for (int n = 0; n < 4; ++n) acc[m][n] = (f32x4){0.f, 0.f, 0.f, 0.f};
    u32x4 ra[4], rb[4];
#pragma unroll
    for (int i = 0; i < 4; ++i) { const int id = tid + 256 * i, row = id >> 3, kc = id & 7;
      ra[i] = *(const u32x4*)(Ag + (size_t)row * lda + kc * 8); rb[i] = *(const u32x4*)(Bg + (size_t)row * ldb + kc * 8); }
    for (int kt = 0; kt < nk; ++kt) {
      __syncthreads();
#pragma unroll
      for (int i = 0; i < 4; ++i) { const int id = tid + 256 * i, row = id >> 3, kc = id & 7;
        *(u32x4*)(As + row * 72 + kc * 8) = ra[i]; *(u32x4*)(Bs + row * 72 + kc * 8) = rb[i]; }
      __syncthreads();
      if (kt + 1 < nk) {
        const int k0 = (kt + 1) * 64;
#pragma unroll
        for (int i = 0; i < 4; ++i) { const int id = tid + 256 * i, row = id >> 3, kc = id & 7;
          ra[i] = *(const u32x4*)(Ag + (size_t)row * lda + k0 + kc * 8); rb[i] = *(const u32x4*)(Bg + (size_t)row * ldb + k0 + kc * 8); }
      }
#pragma unroll
      for (int ks = 0; ks < 2; ++ks) {
        bf16x8 af[4], bfr[4];
#pragma unroll
        for (int m = 0; m < 4; ++m) af[m] = *(const bf16x8*)(As + (wr * 64 + m * 16 + r) * 72 + ks * 32 + gq * 8);
#pragma unroll
        for (int n = 0; n < 4; ++n) bfr[n] = *(const bf16x8*)(Bs + (wc * 64 + n * 16 + r) * 72 + ks * 32 + gq * 8);
#pragma unroll
        for (int m = 0; m < 4; ++m)
#pragma unroll
          for (int n = 0; n < 4; ++n) acc[m][n] = MFMA(bfr[n], af[m], acc[m][n]);
      }
    }
    epi(acc, pm * 128 + wr * 64, pn * 128 + wc * 64, r, gq);
  }
}

__device__ __forceinline__ void prep_phase(const Params& p, int layer) {
  const int tid = opaque_tid(); const int lane = tid & 63, w = tid >> 6;
  const float* __restrict__ convw = p.dn_conv_w + layer * 3 * 768;
  float cw[12][3];
#pragma unroll
  for (int hh = 0; hh < 12; ++hh)
#pragma unroll
    for (int j = 0; j < 3; ++j) cw[hh][j] = convw[j * 768 + hh * 64 + lane];
  const int k_head = lane >> 5, k_pp = lane & 31, k_half = k_pp >> 4, k_i = k_pp & 15;
  const int k_i1 = 256 + k_head * 64 + k_half * 32 + k_i, k_i2 = k_i1 + 16;
  const float k_inv = exp2f(-(float)k_i * (13.287712379549449f / 16.f));
  const int r_half = (lane >> 3) & 1, r_i = lane & 7; const int r_i1 = 1168 + r_half * 16 + r_i, r_i2 = r_i1 + 8;
  const float r_inv = exp2f(-(float)r_i * (13.287712379549449f / 8.f));
  f32x4 gq4 = *(const f32x4*)(p.mla_q_norm_g + layer * 256 + lane * 4);
  const float gk0 = p.mla_kv_norm_g[layer * 128 + lane * 2], gk1 = p.mla_kv_norm_g[layer * 128 + lane * 2 + 1];
  const float dtb = p.dn_dt_bias[layer * 8 + (lane & 7)], alog = -expf(p.dn_a_log[layer * 8 + (lane & 7)]);
  float wkr = 0.f;
  struct PrepIn { bf16_t kt1, kt2, rt1, rt2, ab; u32x2 cq2; unsigned ckv1; bf16_t x0[12], x1[12], x2[12]; };
  auto load_tok = [&](int tok, PrepIn& in) {
    const bool isctx = tok >= NLAT;
    const bf16_t* __restrict__ u = p.U + (size_t)tok * UW;
    const int pos = isctx ? ((tok - NLAT) & 255) : (tok & 4095); const int len = isctx ? 256 : 4096;
    const bool hp = pos > 0, hn = pos < len - 1;
    const bf16_t* __restrict__ r1 = p.QKVraw + (size_t)tok * 768;
    in.kt1 = u[k_i1]; in.kt2 = u[k_i2]; in.rt1 = u[r_i1]; in.rt2 = u[r_i2];
    in.cq2 = *(const u32x2*)(u + 784 + lane * 4);
    in.ckv1 = *(const unsigned*)(u + 1040 + lane * 2);
    in.ab = u[768 + (lane & 15)];
#pragma unroll
    for (int hh = 0; hh < 12; ++hh) { const int col = hh * 64 + lane; in.x0[hh] = hp ? r1[col - 768] : (bf16_t)0; in.x1[hh] = r1[col]; in.x2[hh] = hn ? r1[col + 768] : (bf16_t)0; }
  };
  auto comp_tok = [&](int tok, const PrepIn& in) {
    const bool isctx = tok >= NLAT;
    bf16_t* __restrict__ u = p.U + (size_t)tok * UW;
    const bf16_t kt1 = in.kt1, kt2 = in.kt2, rt1 = in.rt1, rt2 = in.rt2, ab = in.ab; const u32x2 cq2 = in.cq2; const unsigned ckv1 = in.ckv1;
    const bf16_t* x0 = in.x0; const bf16_t* x1 = in.x1; const bf16_t* x2 = in.x2;
    float kr2 = 0.f;
    if (!isctx) {
      const int sq = tok & 4095; const float prow = (float)(sq >> 6), pcol = (float)(sq & 63);
      { float sn, cs; sincosf((k_half ? pcol : prow) * k_inv, &sn, &cs); const float t1 = bf2f(kt1), t2 = bf2f(kt2);
        u[k_i1] = f2bf(t1 * cs - t2 * sn); u[k_i2] = f2bf(t2 * cs + t1 * sn); }
      if (lane < 16) { float sn, cs; sincosf((r_half ? pcol : prow) * r_inv, &sn, &cs); const float t1 = bf2f(rt1), t2 = bf2f(rt2);
        const bf16_t b1 = f2bf(t1 * cs - t2 * sn), b2 = f2bf(t2 * cs + t1 * sn);
        u[r_i1] = b1; u[r_i2] = b2; kr2 = bf2f(b1) * bf2f(b1) + bf2f(b2) * bf2f(b2); }
    } else if (lane < 16) { kr2 = bf2f(rt1) * bf2f(rt1) + bf2f(rt2) * bf2f(rt2); }
    wkr = fmaxf(wkr, wave_sum(kr2));
    {
      float v[4] = {__uint_as_float(cq2[0] << 16), __uint_as_float(cq2[0] & 0xffff0000u), __uint_as_float(cq2[1] << 16), __uint_as_float(cq2[1] & 0xffff0000u)};
      float ss = v[0] * v[0] + v[1] * v[1] + v[2] * v[2] + v[3] * v[3];
      ss = wave_sum(ss); float rs = rsqrtf(ss * (1.f / 256.f) + EPSF);
      *(s16x4*)(u + 784 + lane * 4) = pack4(v[0] * rs * gq4[0], v[1] * rs * gq4[1], v[2] * rs * gq4[2], v[3] * rs * gq4[3]);
      const float c0 = __uint_as_float(ckv1 << 16), c1 = __uint_as_float(ckv1 & 0xffff0000u);
      ss = wave_sum(c0 * c0 + c1 * c1); rs = rsqrtf(ss * (1.f / 128.f) + EPSF);
      *(unsigned*)(u + 1040 + lane * 2) = cvt_pk_bf16(c0 * rs * gk0, c1 * rs * gk1);
    }
    {
      bf16_t* __restrict__ od = p.QKVd + (size_t)tok * 768;
#pragma unroll
      for (int hh = 0; hh < 12; ++hh) {
        float hv = cw[hh][0] * bf2f(x0[hh]) + cw[hh][1] * bf2f(x1[hh]) + cw[hh][2] * bf2f(x2[hh]);
        hv = hv * __builtin_amdgcn_rcpf(1.f + __expf(-hv));
        if (hh < 8) { float ss = wave_sum(hv * hv); hv *= rsqrtf(ss + EPSF); if (hh < 4) hv *= 0.125f; }
        od[hh * 64 + lane] = f2bf(hv);
      }
      const float av = bf2f(ab);
      if (lane < 8) {
        const float xx = av + dtb;
        const float ee = __expf(xx);
        const float sp = xx > 15.f ? xx : (ee < 0.03f ? ee * (1.f - ee * (0.5f - ee * (0.33333334f - 0.25f * ee))) : __logf(1.f + ee));
        p.GB[(size_t)tok * 16 + lane] = alog * sp;
      } else if (lane < 16) {
        p.GB[(size_t)tok * 16 + lane] = 1.f / (1.f + __expf(-av));
      }
    }
  };
  for (int tok = VB * 4 + w; tok < NTOK; tok += NVB * 12) {
    const int tokB = tok + NVB * 4, tokC = tok + NVB * 8; const bool hasB = tokB < NTOK, hasC = tokC < NTOK;
    PrepIn ia, ib, ic;
    load_tok(tok, ia);
    if (hasB) load_tok(tokB, ib);
    if (hasC) load_tok(tokC, ic);
    comp_tok(tok, ia);
    if (hasB) comp_tok(tokB, ib);
    if (hasC) comp_tok(tokC, ic);
  }
  if (lane == 0) __hip_atomic_fetch_max(p.kmx + 64 + layer, __float_as_uint(wkr), __ATOMIC_RELAXED, __HIP_MEMORY_SCOPE_AGENT);
}

__device__ __forceinline__ void dn_chunk(const Params& p, unsigned char* lds) {
  bf16_t* Ks = (bf16_t*)lds; bf16_t* Qs = Ks + 64 * 72; bf16_t* Vs = Qs + 64 * 72;
  float* LsF = (float*)(Vs + 64 * 72); float* LsB = LsF + 4096; float* gcs = LsB + 4096; float* betas = gcs + 128; float* bexp = betas + 128;
  int tid = opaque_tid(); int lane = tid & 63, w = tid >> 6, r = lane & 15, g = lane >> 4;
  u32x4 pq[2], pk[2], pv[2]; float pg = 0.f, pb = 0.f;
#define DNC_DECODE(IT, BH, H, TOKBASE, STF, STB) const int BH = (IT) / 68, H = BH & 3; int TOKBASE, STF, STB; { const int _n = (IT) % 68, _b = BH >> 2; \
    if (_n < 4) { TOKBASE = NLAT + _b * 256 + _n * 64; STF = _n; STB = 3 - _n; } else { TOKBASE = _b * 4096 + (_n - 4) * 64; STF = _n; STB = 4 + 63 - (_n - 4); } }
#define DNC_ISSUE(IT) do { DNC_DECODE(IT, _bh, _h, _tb, _sf, _sb) \
    _Pragma("unroll") for (int i = 0; i < 2; ++i) { const int id = tid + 256 * i, row = id >> 3, kc = id & 7; \
      const bf16_t* src = p.QKVd + (size_t)(_tb + row) * 768 + _h * 64 + kc * 8; \
      pq[i] = *(const u32x4*)src; pk[i] = *(const u32x4*)(src + 256); pv[i] = *(const u32x4*)(src + 512); } \
    if (w < 2) { const int tok = _tb + (w ? 63 - lane : lane); pg = p.GB[(size_t)tok * 16 + w * 4 + _h]; pb = p.GB[(size_t)tok * 16 + 8 + w * 4 + _h]; } } while (0)
  const int it0 = NVB - 1 - VB;
  if (it0 < 2176) DNC_ISSUE(it0);
  for (int it = it0; it < 2176; it += NVB) {
    asm volatile("" : "+v"(tid)); lane = tid & 63; w = tid >> 6; r = lane & 15; g = lane >> 4;
    DNC_DECODE(it, bh, h, tokbase, stf, stb)
    const size_t idxF = (size_t)(bh * 2) * 68 + stf, idxB = (size_t)(bh * 2 + 1) * 68 + stb;
    __syncthreads();
#pragma unroll
    for (int i = 0; i < 2; ++i) {
      const int id = tid + 256 * i, row = id >> 3, kc = id & 7;
      *(u32x4*)(Qs + row * 72 + kc * 8) = pq[i];
      *(u32x4*)(Ks + row * 72 + kc * 8) = pk[i];
      *(u32x4*)(Vs + row * 72 + kc * 8) = pv[i];
    }
    if (w < 2) {
      float gv = pg; const float bv = pb;
#pragma unroll
      for (int o = 1; o < 64; o <<= 1) { float tt = __shfl_up(gv, o); if (lane >= o) gv += tt; }
      gcs[w * 64 + lane] = gv; betas[w * 64 + lane] = bv; bexp[w * 64 + lane] = bv * expf(gv); p.DGC[(w ? idxB : idxF) * 64 + lane] = gv;
    }
    __syncthreads();
    {
      const int a = 16 * w + r, cb = 63 - a;
      const float gF = gcs[a], bF = betas[a], gB = gcs[64 + cb], bB = betas[64 + cb];
      bf16x8 aK[2], aQ[2];
#pragma unroll
      for (int ks = 0; ks < 2; ++ks) { aK[ks] = *(const bf16x8*)(Ks + a * 72 + ks * 32 + g * 8); aQ[ks] = *(const bf16x8*)(Qs + a * 72 + ks * 32 + g * 8); }
#pragma unroll
      for (int jb = 0; jb < 4; ++jb) {
        f32x4 accK = {0.f, 0.f, 0.f, 0.f}, accQ = {0.f, 0.f, 0.f, 0.f};
#pragma unroll
        for (int ks = 0; ks < 2; ++ks) { const bf16x8 bj = *(const bf16x8*)(Ks + (jb * 16 + r) * 72 + ks * 32 + g * 8); accK = MFMA(bj, aK[ks], accK); accQ = MFMA(bj, aQ[ks], accQ); }
        f32x4 LvF, LvB; float ivF[4], ivB[4];
#pragma unroll
        for (int jj = 0; jj < 4; ++jj) {
          const int b2 = 16 * jb + 4 * g + jj, jbk = 63 - b2;
          const float eF = __expf(gF - gcs[b2]), eB = __expf(gB - gcs[64 + jbk]);
          LvF[jj] = (b2 < a) ? bF * accK[jj] * eF : 0.f; ivF[jj] = (b2 <= a) ? accQ[jj] * eF : 0.f;
          LvB[3 - jj] = (jbk < cb) ? bB * accK[jj] * eB : 0.f; ivB[3 - jj] = (jbk <= cb) ? accQ[jj] * eB : 0.f;
        }
        const int j0F = 16 * jb + 4 * g, j0B = 60 - 16 * jb - 4 * g;
        *(f32x4*)(LsF + a * 64 + j0F) = LvF;
        *(f32x4*)(LsB + cb * 64 + j0B) = LvB;
        *(s16x4*)(p.DNI + idxF * 4096 + a * 64 + j0F) = pack4(ivF[0], ivF[1], ivF[2], ivF[3]);
        *(s16x4*)(p.DNI + idxB * 4096 + cb * 64 + j0B) = pack4(ivB[0], ivB[1], ivB[2], ivB[3]);
      }
    }
    __syncthreads();
    if (it + NVB < 2176) DNC_ISSUE(it + NVB);
    asm volatile("" : "+v"(tid)); lane = tid & 63; w = tid >> 6;
    {
      const int sd = w >> 1, col = lane; const bool isK = (w & 1) != 0;
      const float* fac = (isK ? bexp : betas) + sd * 64; const float* Ls = sd ? LsB : LsF;
      const bf16_t* rp = (isK ? Ks : Vs) + (sd ? 63 * 72 : 0) + col; const int rst = sd ? -72 : 72;
      float X[64];
#pragma unroll
      for (int i = 0; i < 64; ++i) X[i] = 0.f;
#pragma unroll
      for (int i = 0; i < 64; ++i) {
        float a0 = bf2f(*rp) * fac[i], a1 = 0.f, a2 = 0.f, a3 = 0.f; rp += rst;
#pragma unroll
        for (int j4 = 0; j4 < (i + 3) / 4; ++j4) {
          const f32x4 lv = *(const f32x4*)(Ls + i * 64 + j4 * 4);
          a0 -= lv[0] * X[j4 * 4]; a1 -= lv[1] * X[j4 * 4 + 1]; a2 -= lv[2] * X[j4 * 4 + 2]; a3 -= lv[3] * X[j4 * 4 + 3];
        }
        X[i] = (a0 + a1) + (a2 + a3);
      }
      bf16_t* dst = (isK ? p.DNW : p.DNU) + (sd ? idxB : idxF) * 4096;
#pragma unroll
      for (int i = 0; i < 64; ++i) dst[i * 64 + col] = f2bf(X[i]);
    }
  }
#undef DNC_DECODE
#undef DNC_ISSUE
}

__device__ __forceinline__ void dn_scan(const Params& p, int item, unsigned char* lds) {
  bf16_t* Wt = (bf16_t*)lds; bf16_t* INs = Wt + 64 * 72; bf16_t* Qs = INs + 64 * 72; bf16_t* KT = Qs + 64 * 72;
  bf16_t* Us = KT + 64 * 72; bf16_t* sT = Us + 64 * 24; bf16_t* vT = sT + 16 * 72; bf16_t* v2T = vT + 16 * 72; float* gcs = (float*)(v2T + 16 * 72);
  const int tid = opaque_tid(), lane = tid & 63, w = tid >> 6, r = lane & 15, g = lane >> 4;
  const int slice = item & 3, seqid = item >> 2, dir = seqid & 1, h = (seqid >> 1) & 3, b = seqid >> 3;
  bf16_t* Od = dir ? p.OB : p.OF;
  f32x4 sreg = {0.f, 0.f, 0.f, 0.f};
  u32x4 rW[2], rI[2], rQ[2], rK[2], rU = {0u, 0u, 0u, 0u}; float rg = 0.f;
  int tokbase_cur = 0, tokbase_nxt = 0;
#define DN_ISSUE(stp) do { const int _st = (stp); const size_t _idx = (size_t)seqid * 68 + _st; \
    tokbase_nxt = (_st < 4) ? NLAT + b * 256 + (dir ? 3 - _st : _st) * 64 : b * 4096 + (dir ? 63 - (_st - 4) : (_st - 4)) * 64; \
    _Pragma("unroll") for (int i = 0; i < 2; ++i) { const int id = tid + 256 * i; \
      rW[i] = ((const u32x4*)(p.DNW + _idx * 4096))[id]; rI[i] = ((const u32x4*)(p.DNI + _idx * 4096))[id]; \
      { const int row = id >> 3, kc = id & 7; rQ[i] = *(const u32x4*)(p.QKVd + (size_t)(tokbase_nxt + (dir ? 63 - row : row)) * 768 + h * 64 + kc * 8); } \
      { const int cc = id & 63, kc2 = id >> 6; rK[i] = *(const u32x4*)(p.QKVd + (size_t)(tokbase_nxt + (dir ? 63 - cc : cc)) * 768 + 256 + h * 64 + kc2 * 8); } } \
    if (tid < 128) rU = *(const u32x4*)(p.DNU + _idx * 4096 + (tid >> 1) * 64 + slice * 16 + (tid & 1) * 8); \
    if (tid < 64) rg = p.DGC[_idx * 64 + tid]; } while (0)
  DN_ISSUE(0);
  for (int step = 0; step < 68; ++step) {
    __syncthreads();
    tokbase_cur = tokbase_nxt;
#pragma unroll
    for (int i = 0; i < 2; ++i) {
      const int id = tid + 256 * i, row = id >> 3, kc = id & 7;
      *(u32x4*)(Wt + row * 72 + kc * 8) = rW[i]; *(u32x4*)(INs + row * 72 + kc * 8) = rI[i]; *(u32x4*)(Qs + row * 72 + kc * 8) = rQ[i];
      const int cc = id & 63, kc2 = id >> 6; const u32x4 kv = rK[i];
#pragma unroll
      for (int e = 0; e < 4; ++e) { KT[(kc2 * 8 + 2 * e) * 72 + cc] = (bf16_t)(kv[e] & 0xffffu); KT[(kc2 * 8 + 2 * e + 1) * 72 + cc] = (bf16_t)(kv[e] >> 16); }
    }
    if (tid < 128) *(u32x4*)(Us + (tid >> 1) * 24 + (tid & 1) * 8) = rU;
    if (tid < 64) gcs[tid] = rg;
    *(s16x4*)(sT + r * 72 + 16 * w + 4 * g) = pack4(sreg[0], sreg[1], sreg[2], sreg[3]);
    __syncthreads();
    if (step + 1 < 68) DN_ISSUE(step + 1);
    const float glast = gcs[63];
    {
      f32x4 acc = {0.f, 0.f, 0.f, 0.f};
#pragma unroll
      for (int ks = 0; ks < 2; ++ks) acc = MFMA(*(const bf16x8*)(Wt + (16 * w + r) * 72 + ks * 32 + g * 8), *(const bf16x8*)(sT + r * 72 + ks * 32 + g * 8), acc);
      float vn[4], v2[4];
#pragma unroll
      for (int jj = 0; jj < 4; ++jj) { const int c = 16 * w + 4 * g + jj; vn[jj] = bf2f(Us[c * 24 + r]) - acc[jj]; v2[jj] = vn[jj] * __expf(glast - gcs[c]); }
      *(s16x4*)(vT + r * 72 + 16 * w + 4 * g) = pack4(vn[0], vn[1], vn[2], vn[3]);
      *(s16x4*)(v2T + r * 72 + 16 * w + 4 * g) = pack4(v2[0], v2[1], v2[2], v2[3]);
    }
    __syncthreads();
    {
      f32x4 a1 = {0.f, 0.f, 0.f, 0.f}, a2 = {0.f, 0.f, 0.f, 0.f}, a3 = {0.f, 0.f, 0.f, 0.f};
#pragma unroll
      for (int ks = 0; ks < 2; ++ks) {
        const bf16x8 sb = *(const bf16x8*)(sT + r * 72 + ks * 32 + g * 8);
        a1 = MFMA(*(const bf16x8*)(Qs + (16 * w + r) * 72 + ks * 32 + g * 8), sb, a1);
        a2 = MFMA(*(const bf16x8*)(INs + (16 * w + r) * 72 + ks * 32 + g * 8), *(const bf16x8*)(vT + r * 72 + ks * 32 + g * 8), a2);
        a3 = MFMA(*(const bf16x8*)(KT + (16 * w + r) * 72 + ks * 32 + g * 8), *(const bf16x8*)(v2T + r * 72 + ks * 32 + g * 8), a3);
      }
#pragma unroll
      for (int jj = 0; jj < 4; ++jj) { const int c = 16 * w + 4 * g + jj; const float o = __expf(gcs[c]) * a1[jj] + a2[jj];
        Od[(size_t)(tokbase_cur + (dir ? 63 - c : c)) * 256 + h * 64 + slice * 16 + r] = f2bf(o); }
      const float eg = __expf(glast);
      sreg = sreg * eg + a3;
    }
  }
#undef DN_ISSUE
}

__device__ __forceinline__ void gated_out(const Params& p, int layer, int M) {
  const int tid = opaque_tid(); const int lane = tid & 63, w = tid >> 6;
  const float ng = p.dn_norm_g[layer * 64 + lane];
  for (int tok0 = (VB * 4 + w) * 4; tok0 < M; tok0 += NVB * 16) {
    bf16_t a[4][4], bq[4][4], zz[4][4];
#pragma unroll
    for (int k = 0; k < 4; ++k)
#pragma unroll
      for (int h = 0; h < 4; ++h) { const size_t tok = tok0 + k;
        a[k][h] = p.OF[tok * 256 + h * 64 + lane]; bq[k][h] = p.OB[tok * 256 + h * 64 + lane]; zz[k][h] = p.U[tok * UW + 512 + h * 64 + lane]; }
#pragma unroll
    for (int k = 0; k < 4; ++k)
#pragma unroll
      for (int h = 0; h < 4; ++h) {
        const float o = bf2f(a[k][h]) + bf2f(bq[k][h]);
        const float ss = wave_sum(o * o);
        const float z = bf2f(zz[k][h]);
        p.XN[(size_t)(tok0 + k) * DM + 256 + h * 64 + lane] = f2bf(o * rsqrtf(ss * (1.f / 64.f) + EPSF) * ng * (z * __builtin_amdgcn_rcpf(1.f + __expf(-z))));
      }
  }
}

template <int DQK, int QB, int MODE>
__device__ __forceinline__ void attn_item(const Params& p, int layer, bool ctxq, int b, int h, int qt, unsigned char* lds) {
  constexpr int LDQ = DQK + 8, NQ = 64 * QB, NKS = DQK / 32, NP = DQK / 2;
  bf16_t* Qs = (bf16_t*)lds; bf16_t* Ks = Qs + NQ * LDQ; bf16_t* Vt = Ks + 64 * LDQ; float* rpbs = (float*)(Vt + 64 * 72);
  const int tid = opaque_tid(), lane = tid & 63, w = tid >> 6, r = lane & 15, g = lane >> 4;
  const int qtok0 = ctxq ? NLAT + b * 256 + qt * NQ : b * 4096 + qt * NQ;
  const int spos0 = qt * NQ;
#define QROW(qb) (MODE == 1 ? (qb) * 64 + w * 16 : (w * QB + (qb)) * 16)
  __syncthreads();
  {
    const bf16_t* qsrc; int qld; float scale;
    if (MODE == 0) { qsrc = p.U + h * 64; qld = UW; scale = 0.125f * 1.4426950408889634f; }
    else if (MODE == 1) { qsrc = p.U + 1200 + h * 64; qld = UW; scale = 0.125f * 1.4426950408889634f; }
    else { qsrc = p.QM + h * 96; qld = 384; scale = 0.10206207261596577f * 1.4426950408889634f; }
    {
      constexpr int CPR = DQK / 8;
#pragma unroll
      for (int i = 0; i < (NQ * CPR) / 256; ++i) { const int id = tid + 256 * i, q = id / CPR, c = id - q * CPR;
        *(u32x4*)(Qs + q * LDQ + c * 8) = *(const u32x4*)(qsrc + (size_t)(qtok0 + q) * qld + c * 8); }
    }
    __syncthreads();
    for (int e = tid; e < NQ * NP; e += 256) {
      const int q = e / NP, pi = e - q * NP;
      int d1, d2; float inv = 0.f; int usecol = 0; bool rot = false;
      if (MODE == 0) { const int half = pi >> 4, i = pi & 15; d1 = half * 32 + i; d2 = d1 + 16; rot = !ctxq; usecol = half; inv = exp2f(-(float)i * (13.287712379549449f / 16.f)); }
      else if (MODE == 2 && pi >= 32) { const int pp = pi - 32, half = pp >> 3, i = pp & 7; d1 = 64 + half * 16 + i; d2 = d1 + 8; rot = !ctxq; usecol = half; inv = exp2f(-(float)i * (13.287712379549449f / 8.f)); }
      else { d1 = 2 * pi; d2 = d1 + 1; }
      const float t1 = bf2f(Qs[q * LDQ + d1]), t2 = bf2f(Qs[q * LDQ + d2]);
      float o1 = t1, o2 = t2;
      if (rot) { const int sp = spos0 + q; const float pos = usecol ? (float)(sp & 63) : (float)(sp >> 6); float sn, cs; sincosf(pos * inv, &sn, &cs); o1 = t1 * cs - t2 * sn; o2 = t2 * cs + t1 * sn; }
      Qs[q * LDQ + d1] = f2bf(o1 * scale); Qs[q * LDQ + d2] = f2bf(o2 * scale);
    }
    if (MODE == 1) for (int e = tid; e < 465; e += 256) rpbs[e] = p.na_rpb[(size_t)(layer * 4 + h) * 465 + e] * 1.4426950408889634f;
  }
  __syncthreads();
  bf16x8 qf[QB][NKS];
#pragma unroll
  for (int qb = 0; qb < QB; ++qb)
#pragma unroll
    for (int ks = 0; ks < NKS; ++ks) qf[qb][ks] = *(const bf16x8*)(Qs + (QROW(qb) + r) * LDQ + ks * 32 + g * 8);
  f32x4 o[QB][4]; float mrun[QB], lrun[QB];
#pragma unroll
  for (int qb = 0; qb < QB; ++qb) { mrun[qb] = -1e30f; lrun[qb] = 0.f;
#pragma unroll
    for (int db = 0; db < 4; ++db) o[qb][db] = (f32x4){0.f, 0.f, 0.f, 0.f}; }
  int nloc = 0, loc0 = 0;
  if (!ctxq) {
    if (MODE == 0) { loc0 = 2 * qt - 2; nloc = 6; }
    else if (MODE == 1) { loc0 = 2 * qt - 4 < 0 ? 0 : (2 * qt - 4 > 56 ? 56 : 2 * qt - 4); nloc = 9; }
    else { loc0 = 0; nloc = 64; }
  }
  const int ntiles = nloc + 4;
  const int kb_lo = (MODE == 1) ? (w == 0 ? 0 : (w == 1 ? 0 : (w == 2 ? 1 : 2))) : 0, kb_hi = (MODE == 1) ? (w == 0 ? 1 : (w == 1 ? 2 : 3)) : 3;
  const int voff = MODE == 0 ? 384 + (h >> 1) * 64 : 1712 + h * 64;
  const int koff = MODE == 0 ? 256 + (h >> 1) * 64 : 1456 + h * 64;
  constexpr int NKC = (DQK * 8) / 256;
  u32x4 rk[NKC], rv[2];
#define ATT_ISSUE(TI) do { const int _ti = (TI); const bool _loc = _ti < nloc; const int _jt = _loc ? loc0 + _ti : _ti - nloc; \
    const int _jtc = _jt < 0 ? 0 : (_jt > 63 ? 63 : _jt); const int _k0 = _loc ? b * 4096 + _jtc * 64 : NLAT + b * 256 + _jt * 64; \
    _Pragma("unroll") for (int i = 0; i < NKC; ++i) { const int id = tid + 256 * i; \
      if (MODE == 2) { const int row = id / 12, kc = id - row * 12; \
        rk[i] = *(const u32x4*)(kc < 8 ? p.KVM + (size_t)(_k0 + row) * 512 + h * 128 + kc * 8 : p.U + (size_t)(_k0 + row) * UW + 1168 + (kc - 8) * 8); } \
      else { const int row = id >> 3, kc = id & 7; rk[i] = *(const u32x4*)(p.U + (size_t)(_k0 + row) * UW + koff + kc * 8); } } \
    _Pragma("unroll") for (int i = 0; i < 2; ++i) { const int key = 2 * (tid & 31) + i, dc = tid >> 5; \
      rv[i] = *(const u32x4*)(MODE == 2 ? p.KVM + (size_t)(_k0 + key) * 512 + h * 128 + 64 + dc * 8 : p.U + (size_t)(_k0 + key) * UW + voff + dc * 8); } } while (0)
  ATT_ISSUE(0);
  for (int ti = 0; ti < ntiles; ++ti) {
    const bool isloc = ti < nloc;
    const int jt = isloc ? loc0 + ti : ti - nloc;
    const bool oob = jt < 0 || jt > 63;
    __syncthreads();
#pragma unroll
    for (int i = 0; i < NKC; ++i) { const int id = tid + 256 * i;
      if (MODE == 2) { const int row = id / 12, kc = id - row * 12; *(u32x4*)(Ks + row * LDQ + kc * 8) = rk[i]; }
      else { const int row = id >> 3, kc = id & 7; *(u32x4*)(Ks + row * LDQ + kc * 8) = rk[i]; } }
    {
      const int kp = tid & 31, dc = tid >> 5; const u32x4 va = rv[0], vb = rv[1];
#pragma unroll
      for (int e = 0; e < 4; ++e) {
        *(unsigned*)(Vt + (dc * 8 + 2 * e) * 72 + 2 * kp) = (va[e] & 0xffffu) | (vb[e] << 16);
        *(unsigned*)(Vt + (dc * 8 + 2 * e + 1) * 72 + 2 * kp) = (va[e] >> 16) | (vb[e] & 0xffff0000u);
      }
    }
    __syncthreads();
    if (ti + 1 < ntiles) ATT_ISSUE(ti + 1);
    f32x4 s[QB][4];
#pragma unroll
    for (int qb = 0; qb < QB; ++qb)
#pragma unroll
      for (int kb = 0; kb < 4; ++kb) s[qb][kb] = (f32x4){0.f, 0.f, 0.f, 0.f};
    const bool narrow = (MODE == 1) && isloc;
#pragma unroll
    for (int kb = 0; kb < 4; ++kb) {
      if (narrow && (kb < kb_lo || kb > kb_hi)) continue;
#pragma unroll
      for (int ks = 0; ks < NKS; ++ks) {
        const bf16x8 a = *(const bf16x8*)(Ks + (kb * 16 + r) * LDQ + ks * 32 + g * 8);
#pragma unroll
        for (int qb = 0; qb < QB; ++qb) s[qb][kb] = MFMA(a, qf[qb][ks], s[qb][kb]);
      }
    }
    bf16x8 pf[QB][2];
#pragma unroll
    for (int qb = 0; qb < QB; ++qb) {
      const int qi = QROW(qb) + r;
      float mx = -1e30f;
#pragma unroll
      for (int kb = 0; kb < 4; ++kb)
#pragma unroll
        for (int jj = 0; jj < 4; ++jj) {
          float sv = s[qb][kb][jj];
          if (isloc && MODE == 0) { const int key = kb * 16 + 4 * g + jj; const int dlt = (qt * NQ + qi) - (jt * 64 + key); if (oob || dlt > 128 || dlt < -128) sv = -1e30f; }
          if (isloc && MODE == 1) { const int key = kb * 16 + 4 * g + jj; const int qc = qi & 63, rq = 2 * qt + (qi >> 6);
            int cs0 = qc - 8; cs0 = cs0 < 0 ? 0 : (cs0 > 48 ? 48 : cs0); int rs0 = rq - 4; rs0 = rs0 < 0 ? 0 : (rs0 > 56 ? 56 : rs0);
            if (!oob && kb >= kb_lo && kb <= kb_hi && jt >= rs0 && jt < rs0 + 8 && key >= cs0 && key < cs0 + 16) sv += rpbs[(jt - rq + 7) * 31 + (key - qc + 15)]; else sv = -1e30f; }
          s[qb][kb][jj] = sv; mx = fmaxf(mx, sv);
        }
      mx = fmaxf(mx, __shfl_xor(mx, 16)); mx = fmaxf(mx, __shfl_xor(mx, 32));
      const float mnew = fmaxf(mrun[qb], mx);
      const float alpha = __builtin_amdgcn_exp2f(mrun[qb] - mnew);
      mrun[qb] = mnew;
      float ps = 0.f; float pv[4][4];
#pragma unroll
      for (int kb = 0; kb < 4; ++kb)
#pragma unroll
        for (int jj = 0; jj < 4; ++jj) { const float sv = s[qb][kb][jj]; const float pe = (MODE == 2 || sv > -1e29f) ? __builtin_amdgcn_exp2f(sv - mnew) : 0.f; pv[kb][jj] = pe; ps += pe; }
      lrun[qb] = lrun[qb] * alpha + ps;
#pragma unroll
      for (int db = 0; db < 4; ++db) o[qb][db] = o[qb][db] * alpha;
#pragma unroll
      for (int k2 = 0; k2 < 2; ++k2) {
        const s16x4 lo = pack4(pv[2 * k2][0], pv[2 * k2][1], pv[2 * k2][2], pv[2 * k2][3]);
        const s16x4 hi = pack4(pv[2 * k2 + 1][0], pv[2 * k2 + 1][1], pv[2 * k2 + 1][2], pv[2 * k2 + 1][3]);
        pf[qb][k2] = __builtin_shufflevector(lo, hi, 0, 1, 2, 3, 4, 5, 6, 7);
      }
    }
#pragma unroll
    for (int k2 = 0; k2 < 2; ++k2) {
      if (narrow && ((k2 == 0 && kb_lo > 1) || (k2 == 1 && kb_hi < 2))) continue;
#pragma unroll
      for (int db = 0; db < 4; ++db) {
        const s16x4 lo = *(const s16x4*)(Vt + (db * 16 + r) * 72 + k2 * 32 + 4 * g);
        const s16x4 hi = *(const s16x4*)(Vt + (db * 16 + r) * 72 + k2 * 32 + 16 + 4 * g);
        const bf16x8 a = __builtin_shufflevector(lo, hi, 0, 1, 2, 3, 4, 5, 6, 7);
#pragma unroll
        for (int qb = 0; qb < QB; ++qb) o[qb][db] = MFMA(a, pf[qb][k2], o[qb][db]);
      }
    }
  }
  const int ycol = (MODE == 0 ? 0 : (MODE == 1 ? 768 : 512)) + h * 64;
#pragma unroll
  for (int qb = 0; qb < QB; ++qb) {
    float lt = lrun[qb]; lt += __shfl_xor(lt, 16); lt += __shfl_xor(lt, 32);
    if (MODE == 0) lt += __builtin_amdgcn_exp2f(p.swa_sink[layer * 4 + h] * 1.4426950408889634f - mrun[qb]);
    const float inv = 1.f / lt;
    const size_t qtok = (size_t)qtok0 + QROW(qb) + r;
#pragma unroll
    for (int db = 0; db < 4; ++db) *(s16x4*)(p.XN + qtok * DM + ycol + db * 16 + 4 * g) = pack4(o[qb][db][0] * inv, o[qb][db][1] * inv, o[qb][db][2] * inv, o[qb][db][3] * inv);
  }
}
#undef QROW

template <bool FAST>
__device__ __forceinline__ void mla_loop(const Params& p, int b, int h, int tid, int r, int g, bf16_t* Kb0, bf16_t* Kb1, bf16_t* Vt,
                                         const bf16x8 (&qf)[2][3], f32x4 (&o)[2][4], f32x4 (&o5)[2], float (&mrun)[2], float (&lrun)[2]) {
  constexpr int LDQ = 104;
  u32x4 rk[3], rv[2];
#define MLA_TOK0(TI) ((TI) < 4 ? NLAT + b * 256 + (TI) * 64 : b * 4096 + ((TI) - 4) * 64)
#define MLA_LOADK(TI) do { const int _k0 = MLA_TOK0(TI); _Pragma("unroll") for (int i = 0; i < 3; ++i) { const int id = tid + 256 * i, row = id / 12, kc = id - row * 12; \
      rk[i] = *(const u32x4*)(kc < 8 ? p.KVM + (size_t)(_k0 + row) * 512 + h * 128 + kc * 8 : p.U + (size_t)(_k0 + row) * UW + 1168 + (kc - 8) * 8); } } while (0)
#define MLA_LOADV(TI) do { const int _k0 = MLA_TOK0(TI); _Pragma("unroll") for (int i = 0; i < 2; ++i) { const int key = 2 * (tid & 31) + i, dc = tid >> 5; \
      rv[i] = *(const u32x4*)(p.KVM + (size_t)(_k0 + key) * 512 + h * 128 + 64 + dc * 8); } } while (0)
#define MLA_STOREK(KB) do { _Pragma("unroll") for (int i = 0; i < 3; ++i) { const int id = tid + 256 * i, row = id / 12, kc = id - row * 12; *(u32x4*)((KB) + row * LDQ + kc * 8) = rk[i]; } } while (0)
  MLA_LOADK(0); MLA_LOADV(0);
  MLA_STOREK(Kb0);
  MLA_LOADK(1);
  __syncthreads();
  f32x4 sc[2][4];
#pragma unroll
  for (int qb = 0; qb < 2; ++qb)
#pragma unroll
    for (int kb = 0; kb < 4; ++kb) sc[qb][kb] = (f32x4){0.f, 0.f, 0.f, 0.f};
#pragma unroll
  for (int kb = 0; kb < 4; ++kb)
#pragma unroll
    for (int ks = 0; ks < 3; ++ks) { const bf16x8 a = *(const bf16x8*)(Kb0 + (kb * 16 + r) * LDQ + ks * 32 + g * 8);
#pragma unroll
      for (int qb = 0; qb < 2; ++qb) sc[qb][kb] = MFMA(a, qf[qb][ks], sc[qb][kb]); }
  for (int ti = 0; ti < 68; ++ti) {
    const bool has_next = ti + 1 < 68;
    const bf16_t* Kn = ((ti + 1) & 1) ? Kb1 : Kb0;
    __syncthreads();
    {
      const int kp = tid & 31, dc = tid >> 5; const u32x4 va = rv[0], vb = rv[1];
#pragma unroll
      for (int e = 0; e < 4; ++e) {
        *(unsigned*)(Vt + (dc * 8 + 2 * e) * 72 + 2 * kp) = (va[e] & 0xffffu) | (vb[e] << 16);
        *(unsigned*)(Vt + (dc * 8 + 2 * e + 1) * 72 + 2 * kp) = (va[e] >> 16) | (vb[e] & 0xffff0000u);
      }
    }
    if (has_next) MLA_STOREK((bf16_t*)Kn);
    __syncthreads();
    if (ti + 2 < 68) MLA_LOADK(ti + 2);
    if (has_next) MLA_LOADV(ti + 1);
    float mnew[2] = {0.f, 0.f};
    if (!FAST) {
#pragma unroll
      for (int qb = 0; qb < 2; ++qb) {
        float mk[4];
#pragma unroll
        for (int kb = 0; kb < 4; ++kb) mk[kb] = fmaxf(fmaxf(sc[qb][kb][0], sc[qb][kb][1]), fmaxf(sc[qb][kb][2], sc[qb][kb][3]));
        float mx = fmaxf(fmaxf(mk[0], mk[1]), fmaxf(mk[2], mk[3]));
        mx = fmaxf(mx, __shfl_xor(mx, 16)); mx = fmaxf(mx, __shfl_xor(mx, 32));
        mnew[qb] = fmaxf(mrun[qb], mx);
        const float alpha = __builtin_amdgcn_exp2f(mrun[qb] - mnew[qb]);
        mrun[qb] = mnew[qb]; lrun[qb] *= alpha;
#pragma unroll
        for (int db = 0; db < 4; ++db) o[qb][db] = o[qb][db] * alpha;
      }
    }
    f32x4 sn[2][4]; float pv[2][4][4];
#pragma unroll
    for (int qb = 0; qb < 2; ++qb)
#pragma unroll
      for (int kb = 0; kb < 4; ++kb) sn[qb][kb] = (f32x4){0.f, 0.f, 0.f, 0.f};
#pragma unroll
    for (int kb = 0; kb < 4; ++kb) {
      if (has_next) {
#pragma unroll
        for (int ks = 0; ks < 3; ++ks) { const bf16x8 a = *(const bf16x8*)(Kn + (kb * 16 + r) * LDQ + ks * 32 + g * 8);
#pragma unroll
          for (int qb = 0; qb < 2; ++qb) sn[qb][kb] = MFMA(a, qf[qb][ks], sn[qb][kb]); }
      }
#pragma unroll
      for (int qb = 0; qb < 2; ++qb) {
#pragma unroll
        for (int jj = 0; jj < 4; ++jj) pv[qb][kb][jj] = FAST ? __builtin_amdgcn_exp2f(sc[qb][kb][jj]) : __builtin_amdgcn_exp2f(sc[qb][kb][jj] - mnew[qb]);
        if (!FAST) lrun[qb] += (pv[qb][kb][0] + pv[qb][kb][1]) + (pv[qb][kb][2] + pv[qb][kb][3]);
      }
    }
#pragma unroll
    for (int k2 = 0; k2 < 2; ++k2) {
      bf16x8 pf[2];
#pragma unroll
      for (int qb = 0; qb < 2; ++qb) {
        const s16x4 lo = pack4(pv[qb][2 * k2][0], pv[qb][2 * k2][1], pv[qb][2 * k2][2], pv[qb][2 * k2][3]);
        const s16x4 hi = pack4(pv[qb][2 * k2 + 1][0], pv[qb][2 * k2 + 1][1], pv[qb][2 * k2 + 1][2], pv[qb][2 * k2 + 1][3]);
        pf[qb] = __builtin_shufflevector(lo, hi, 0, 1, 2, 3, 4, 5, 6, 7);
      }
#pragma unroll
      for (int db = 0; db < (FAST ? 5 : 4); ++db) {
        const s16x4 lo = *(const s16x4*)(Vt + (db * 16 + r) * 72 + k2 * 32 + 4 * g);
        const s16x4 hi = *(const s16x4*)(Vt + (db * 16 + r) * 72 + k2 * 32 + 16 + 4 * g);
        const bf16x8 a = __builtin_shufflevector(lo, hi, 0, 1, 2, 3, 4, 5, 6, 7);
#pragma unroll
        for (int qb = 0; qb < 2; ++qb) { if (db < 4) o[qb][db < 4 ? db : 0] = MFMA(a, pf[qb], o[qb][db < 4 ? db : 0]); else o5[qb] = MFMA(a, pf[qb], o5[qb]); }
      }
    }
#pragma unroll
    for (int qb = 0; qb < 2; ++qb)
#pragma unroll
      for (int kb = 0; kb < 4; ++kb) sc[qb][kb] = sn[qb][kb];
  }
#undef MLA_TOK0
#undef MLA_LOADK
#undef MLA_LOADV
#undef MLA_STOREK
}

__device__ __forceinline__ void mla_fast128(const Params& p, int b, int h, int tid, int r, int g, bf16_t* Kt, bf16_t* Vt,
                                            const bf16x8 (&qf)[2][3], f32x4 (&o)[2][4], f32x4 (&o5)[2]) {
  constexpr int LDQ = 104, LDV = 136;
  u32x4 rk[6], rv[4];
#define M128_TOK0(TI) ((TI) < 2 ? NLAT + b * 256 + (TI) * 128 : b * 4096 + ((TI) - 2) * 128)
#define M128_LOAD(TI) do { const int _k0 = M128_TOK0(TI); \
    _Pragma("unroll") for (int i = 0; i < 6; ++i) { const int id = tid + 256 * i, row = id / 12, kc = id - row * 12; \
      rk[i] = *(const u32x4*)(kc < 8 ? p.KVM + (size_t)(_k0 + row) * 512 + h * 128 + kc * 8 : p.U + (size_t)(_k0 + row) * UW + 1168 + (kc - 8) * 8); } \
    _Pragma("unroll") for (int i = 0; i < 4; ++i) { const int key = 2 * (tid & 63) + (i & 1), dc = (tid >> 6) + 4 * (i >> 1); \
      rv[i] = *(const u32x4*)(p.KVM + (size_t)(_k0 + key) * 512 + h * 128 + 64 + dc * 8); } } while (0)
  M128_LOAD(0);
  for (int ti = 0; ti < 34; ++ti) {
    __syncthreads();
    if (ti == 0) for (int e = tid; e < 16 * LDV; e += 256) Vt[64 * LDV + e] = (e < LDV) ? (bf16_t)0x3F80 : (bf16_t)0;
#pragma unroll
    for (int i = 0; i < 6; ++i) { const int id = tid + 256 * i, row = id / 12, kc = id - row * 12; *(u32x4*)(Kt + row * LDQ + kc * 8) = rk[i]; }
#pragma unroll
    for (int i2 = 0; i2 < 2; ++i2) {
      const int kp = tid & 63, dc = (tid >> 6) + 4 * i2; const u32x4 va = rv[2 * i2], vb = rv[2 * i2 + 1];
#pragma unroll
      for (int e = 0; e < 4; ++e) {
        *(unsigned*)(Vt + (dc * 8 + 2 * e) * LDV + 2 * kp) = (va[e] & 0xffffu) | (vb[e] << 16);
        *(unsigned*)(Vt + (dc * 8 + 2 * e + 1) * LDV + 2 * kp) = (va[e] >> 16) | (vb[e] & 0xffff0000u);
      }
    }
    __syncthreads();
    if (ti + 1 < 34) M128_LOAD(ti + 1);
#pragma unroll
    for (int k2 = 0; k2 < 4; ++k2) {
      f32x4 sc[2][2];
#pragma unroll
      for (int qb = 0; qb < 2; ++qb) { sc[qb][0] = (f32x4){0.f, 0.f, 0.f, 0.f}; sc[qb][1] = (f32x4){0.f, 0.f, 0.f, 0.f}; }
#pragma unroll
      for (int kk = 0; kk < 2; ++kk)
#pragma unroll
        for (int ks = 0; ks < 3; ++ks) { const bf16x8 a = *(const bf16x8*)(Kt + ((2 * k2 + kk) * 16 + r) * LDQ + ks * 32 + g * 8);
#pragma unroll
          for (int qb = 0; qb < 2; ++qb) sc[qb][kk] = MFMA(a, qf[qb][ks], sc[qb][kk]); }
      bf16x8 pf[2];
#pragma unroll
      for (int qb = 0; qb < 2; ++qb) {
        const s16x4 lo = pack4(__builtin_amdgcn_exp2f(sc[qb][0][0]), __builtin_amdgcn_exp2f(sc[qb][0][1]), __builtin_amdgcn_exp2f(sc[qb][0][2]), __builtin_amdgcn_exp2f(sc[qb][0][3]));
        const s16x4 hi = pack4(__builtin_amdgcn_exp2f(sc[qb][1][0]), __builtin_amdgcn_exp2f(sc[qb][1][1]), __builtin_amdgcn_exp2f(sc[qb][1][2]), __builtin_amdgcn_exp2f(sc[qb][1][3]));
        pf[qb] = __builtin_shufflevector(lo, hi, 0, 1, 2, 3, 4, 5, 6, 7);
      }
#pragma unroll
      for (int db = 0; db < 5; ++db) {
        const s16x4 lo = *(const s16x4*)(Vt + (db * 16 + r) * LDV + k2 * 32 + 4 * g);
        const s16x4 hi = *(const s16x4*)(Vt + (db * 16 + r) * LDV + k2 * 32 + 16 + 4 * g);
        const bf16x8 a = __builtin_shufflevector(lo, hi, 0, 1, 2, 3, 4, 5, 6, 7);
#pragma unroll
        for (int qb = 0; qb < 2; ++qb) { if (db < 4) o[qb][db < 4 ? db : 0] = MFMA(a, pf[qb], o[qb][db < 4 ? db : 0]); else o5[qb] = MFMA(a, pf[qb], o5[qb]); }
      }
    }
  }
#undef M128_TOK0
#undef M128_LOAD
}

__device__ __forceinline__ void mla_item(const Params& p, int layer, int b, int h, int qt, unsigned char* lds) {
  constexpr int LDQ = 104;
  bf16_t* Qs = (bf16_t*)lds; bf16_t* Kb0 = Qs + 128 * LDQ; bf16_t* Kb1 = Kb0 + 64 * LDQ; bf16_t* Vt = Kb1 + 64 * LDQ;
  float* qn = (float*)(Vt + 80 * 72);
  const int tid = opaque_tid(), lane = tid & 63, w = tid >> 6, r = lane & 15, g = lane >> 4;
  const int qtok0 = b * 4096 + qt * 128, spos0 = qt * 128;
  const unsigned kn_bits = __hip_atomic_load(p.kmx + layer * 32 + b * 4 + h, __ATOMIC_RELAXED, __HIP_MEMORY_SCOPE_AGENT), kr_bits = __hip_atomic_load(p.kmx + 64 + layer, __ATOMIC_RELAXED, __HIP_MEMORY_SCOPE_AGENT);
  __syncthreads();
  {
    const bf16_t* qsrc = p.QM + h * 96;
#pragma unroll
    for (int i = 0; i < 6; ++i) { const int id = tid + 256 * i, q = id / 12, c = id - q * 12;
      *(u32x4*)(Qs + q * LDQ + c * 8) = *(const u32x4*)(qsrc + (size_t)(qtok0 + q) * 384 + c * 8); }
    for (int e = tid; e < 16 * 72; e += 256) Vt[64 * 72 + e] = (e < 72) ? (bf16_t)0x3F80 : (bf16_t)0;
    __syncthreads();
    const float scale = 0.10206207261596577f * 1.4426950408889634f;
    for (int e = tid; e < 128 * 48; e += 256) {
      const int q = e / 48, pi = e - q * 48;
      int d1, d2; float inv = 0.f; int usecol = 0; bool rot = false;
      if (pi >= 32) { const int pp = pi - 32, hf = pp >> 3, i = pp & 7; d1 = 64 + hf * 16 + i; d2 = d1 + 8; rot = true; usecol = hf; inv = exp2f(-(float)i * (13.287712379549449f / 8.f)); }
      else { d1 = 2 * pi; d2 = d1 + 1; }
      const float t1 = bf2f(Qs[q * LDQ + d1]), t2 = bf2f(Qs[q * LDQ + d2]);
      float o1 = t1, o2 = t2;
      if (rot) { const int sp = spos0 + q; const float pos = usecol ? (float)(sp & 63) : (float)(sp >> 6); float sn, cs; sincosf(pos * inv, &sn, &cs); o1 = t1 * cs - t2 * sn; o2 = t2 * cs + t1 * sn; }
      Qs[q * LDQ + d1] = f2bf(o1 * scale); Qs[q * LDQ + d2] = f2bf(o2 * scale);
    }
    __syncthreads();
    if (tid < 128) { float ss = 0.f;
#pragma unroll
      for (int c = 0; c < 12; ++c) { const u32x4 v = *(const u32x4*)(Qs + tid * LDQ + c * 8);
#pragma unroll
        for (int e = 0; e < 4; ++e) { const float a = __uint_as_float(v[e] << 16), bb = __uint_as_float(v[e] & 0xffff0000u); ss += a * a + bb * bb; } }
      qn[tid] = ss; }
  }
  __syncthreads();
  bf16x8 qf[2][3];
#pragma unroll
  for (int qb = 0; qb < 2; ++qb)
#pragma unroll
    for (int ks = 0; ks < 3; ++ks) qf[qb][ks] = *(const bf16x8*)(Qs + ((w * 2 + qb) * 16 + r) * LDQ + ks * 32 + g * 8);
  float qmax2 = fmaxf(qn[lane], qn[lane + 64]);
#pragma unroll
  for (int of = 32; of >= 1; of >>= 1) qmax2 = fmaxf(qmax2, __shfl_xor(qmax2, of));
  const float kmax2 = __uint_as_float(kn_bits) + __uint_as_float(kr_bits);
  const float bound = sqrtf(qmax2 * kmax2);
  const bool fast = bound < 100.f;
  f32x4 o[2][4], o5[2]; float mrun[2], lrun[2];
#pragma unroll
  for (int qb = 0; qb < 2; ++qb) { mrun[qb] = -1e30f; lrun[qb] = 0.f; o5[qb] = (f32x4){0.f, 0.f, 0.f, 0.f};
#pragma unroll
    for (int db = 0; db < 4; ++db) o[qb][db] = (f32x4){0.f, 0.f, 0.f, 0.f}; }
  if (fast) mla_fast128(p, b, h, tid, r, g, Qs, Qs + 128 * LDQ, qf, o, o5);
  else mla_loop<false>(p, b, h, tid, r, g, Kb0, Kb1, Vt, qf, o, o5, mrun, lrun);
  const int ycol = 512 + h * 64;
#pragma unroll
  for (int qb = 0; qb < 2; ++qb) {
    float lt;
    if (fast) lt = __shfl(o5[qb][0], r);
    else { lt = lrun[qb]; lt += __shfl_xor(lt, 16); lt += __shfl_xor(lt, 32); }
    const float inv = 1.f / lt;
    const size_t qtok = (size_t)qtok0 + (w * 2 + qb) * 16 + r;
#pragma unroll
    for (int db = 0; db < 4; ++db) *(s16x4*)(p.XN + qtok * DM + ycol + db * 16 + 4 * g) = pack4(o[qb][db][0] * inv, o[qb][db][1] * inv, o[qb][db][2] * inv, o[qb][db][3] * inv);
  }
}

__device__ __forceinline__ void mixer_phase(const Params& p, int layer, bool need_ctx, unsigned char* lds, volatile int* sitem) {
  for (int it = VB; it < 256; it += NVB) dn_scan(p, it, lds);
  const int half = raw_tid() >> 8;
  const int nMc = need_ctx ? 64 : 0, nSc = need_ctx ? 64 : 0;
  const int e0 = 1024, e1 = e0 + nMc, e2 = e1 + 1024, e3 = e2 + 1024, e4 = e3 + nSc, e5 = e4 + nSc;
  {
    const int x0 = (int)xb_xcc_id() & 7;
    for (int dx = 0; dx < 8; ++dx) {
      const int x = (x0 + dx) & 7;
      for (;;) {
        __syncthreads();
        if (raw_tid() == 0) *sitem = (int)atomicAdd(p.cnt + 16 + layer * 8 + x, 1u);
        __syncthreads();
        const int pr = *sitem;
        if (pr >= 64) break;
        const int li = 2 * pr + half, bh = 4 * x + (li >> 5);
        mla_item(p, layer, bh >> 2, bh & 3, li & 31, lds);
      }
    }
  }
  for (;;) {
    __syncthreads();
    if (raw_tid() == 0) *sitem = (int)atomicAdd(p.cnt + layer, 1u);
    __syncthreads();
    const int it = e0 + 2 * (*sitem) + half;
    if (it >= e5) break;
    if (it < e1) { const int j = it - e0; attn_item<96, 2, 2>(p, layer, true, j >> 3, (j >> 1) & 3, j & 1, lds); }
    else if (it < e2) { const int j = it - e1; attn_item<64, 2, 0>(p, layer, false, j >> 7, (j >> 5) & 3, j & 31, lds); }
    else if (it < e3) { const int j = it - e2; attn_item<64, 2, 1>(p, layer, false, j >> 7, (j >> 5) & 3, j & 31, lds); }
    else if (it < e4) { const int j = it - e3; attn_item<64, 2, 0>(p, layer, true, j >> 3, (j >> 1) & 3, j & 1, lds); }
    else { const int j = it - e4; attn_item<64, 2, 1>(p, layer, true, j >> 3, (j >> 1) & 3, j & 1, lds); }
  }
}

extern __shared__ __attribute__((aligned(16))) unsigned char dyn_shm[];
namespace g256 {
constexpr int BM = 256, BK = 64, HALF = 128, NXCD = 8, WGM = 8, HT = HALF * BK;
__device__ __forceinline__ int lds_byte(int r, int c) { int st = (r >> 4) * 2 + (c >> 5), rr = r & 15, cc = c & 31, ob = rr * 64 + cc * 2; return st * 1024 + (ob ^ (((ob >> 9) & 1) << 5)); }
__device__ __forceinline__ void stage_rc(int b, int& R, int& C) { int st = b / 1024, sb = b % 1024, swz = sb ^ (((sb >> 9) & 1) << 5); R = (st >> 1) * 16 + swz / 64; C = (st & 1) * 32 + (swz % 64) / 2; }
}
__device__ __forceinline__ void gemm64_ctx(const bf16_t* __restrict__ A, int lda, const bf16_t* __restrict__ Bt, int ldb, int K,
                                           const float* srcC, float* dstC, const float* mod, int gi, float fac, unsigned char* lds) {
  constexpr int LDT = 136;
  bf16_t* As = (bf16_t*)lds; bf16_t* Bs = As + 64 * LDT;
  const int tid = opaque_tid(), lane = tid & 63, w = tid >> 6, wr = w >> 1, wc = w & 1, r = lane & 15, gq = lane >> 4;
  const int ntn = DM / 64, nt = (NCTX / 64) * ntn, nk = K / 128;
  for (int tile = VB; tile < nt; tile += NVB) {
    const int pm = tile / ntn, pn = tile - pm * ntn;
    const bf16_t* Ag = A + (size_t)(pm * 64) * lda; const bf16_t* Bg = Bt + (size_t)(pn * 64) * ldb;
    f32x4 acc[2][2];
#pragma unroll
    for (int m = 0; m < 2; ++m)
#pragma unroll
      for (int n = 0; n < 2; ++n) acc[m][n] = (f32x4){0.f, 0.f, 0.f, 0.f};
    u32x4 ra[2][4], rb[2][4];
#define G64_LOAD(S, KT) do { const int _k0 = (KT) * 128; _Pragma("unroll") for (int i = 0; i < 4; ++i) { const int id = tid + 256 * i, row = id >> 4, kc = id & 15; \
      ra[S][i] = *(const u32x4*)(Ag + (size_t)row * lda + _k0 + kc * 8); rb[S][i] = *(const u32x4*)(Bg + (size_t)row * ldb + _k0 + kc * 8); } } while (0)
#define G64_STEP(S, KT) do { __syncthreads(); \
      _Pragma("unroll") for (int i = 0; i < 4; ++i) { const int id = tid + 256 * i, row = id >> 4, kc = id & 15; \
        *(u32x4*)(As + row * LDT + kc * 8) = ra[S][i]; *(u32x4*)(Bs + row * LDT + kc * 8) = rb[S][i]; } \
      __syncthreads(); \
      if ((KT) + 2 < nk) G64_LOAD(S, (KT) + 2); \
      _Pragma("unroll") for (int ks = 0; ks < 4; ++ks) { bf16x8 af[2], bfr[2]; \
        _Pragma("unroll") for (int m = 0; m < 2; ++m) af[m] = *(const bf16x8*)(As + (wr * 32 + m * 16 + r) * LDT + ks * 32 + gq * 8); \
        _Pragma("unroll") for (int n = 0; n < 2; ++n) bfr[n] = *(const bf16x8*)(Bs + (wc * 32 + n * 16 + r) * LDT + ks * 32 + gq * 8); \
        _Pragma("unroll") for (int m = 0; m < 2; ++m) _Pragma("unroll") for (int n = 0; n < 2; ++n) acc[m][n] = MFMA(bfr[n], af[m], acc[m][n]); } } while (0)
    G64_LOAD(0, 0); G64_LOAD(1, 1);
    for (int kt = 0; kt < nk; kt += 2) { G64_STEP(0, kt); G64_STEP(1, kt + 1); }
#undef G64_LOAD
#undef G64_STEP
    const float* mp = mod + 8 * 9216 + gi * 1024;
#pragma unroll
    for (int m = 0; m < 2; ++m) {
      const int row = pm * 64 + wr * 32 + m * 16 + r;
#pragma unroll
      for (int n = 0; n < 2; ++n) {
        const int col = pn * 64 + wc * 32 + n * 16 + 4 * gq;
        const f32x4 gt = *(const f32x4*)(mp + col);
        const f32x4 sv = *(const f32x4*)(srcC + (size_t)row * DM + col);
        *(f32x4*)(dstC + (size_t)row * DM + col) = sv + (gt * fac) * acc[m][n];
      }
    }
  }
}
template <class Epi>
__device__ __forceinline__ void gemm256_phase(const bf16_t* __restrict__ A, const bf16_t* __restrict__ Bt, int M, int N, int K, const Epi& epi) {
  using namespace g256;
  typedef __attribute__((address_space(3))) unsigned char lds_u8;
  lds_u8* shm8 = (lds_u8*)dyn_shm;
#define SA(b, h) (((b) * 2 + (h)) * (HT * 2))
#define SB(b, h) ((4 + (b) * 2 + (h)) * (HT * 2))
#define STAGE(bufoff, gbase, voff) do { _Pragma("unroll") for (int _i = 0; _i < 2; ++_i) \
      __builtin_amdgcn_global_load_lds((const unsigned*)((const char*)(gbase) + (voff)[_i]), (__attribute__((address_space(3))) unsigned*)(shm8 + (bufoff) + ldsw + _i * 8192), 16, 0, 0); } while (0)
#define LDA(dst, b, h) _Pragma("unroll") for (int m = 0; m < 4; ++m) _Pragma("unroll") for (int k = 0; k < 2; ++k) \
    dst[m][k] = *(const __attribute__((address_space(3))) bf16x8*)(shm8 + SA(b, h) + aoff + m * 2048 + k * 1024)
#define LDB(dst, b, h) _Pragma("unroll") for (int n = 0; n < 2; ++n) _Pragma("unroll") for (int k = 0; k < 2; ++k) \
    dst[n][k] = *(const __attribute__((address_space(3))) bf16x8*)(shm8 + SB(b, h) + boff + n * 2048 + k * 1024)
#define MMA(ai, bj, At_, Bt_) do { __builtin_amdgcn_s_setprio(1); \
    _Pragma("unroll") for (int m = 0; m < 4; ++m) _Pragma("unroll") for (int n = 0; n < 2; ++n) _Pragma("unroll") for (int k = 0; k < 2; ++k) \
      acc[ai][bj][m][n] = __builtin_amdgcn_mfma_f32_16x16x32_bf16(Bt_[n][k], At_[m][k], acc[ai][bj][m][n], 0, 0, 0); \
    __builtin_amdgcn_s_setprio(0); } while (0)
#define WAIT_V(n) asm volatile("s_waitcnt vmcnt(" #n ")" ::: "memory")
#define WAIT_L(n) asm volatile("s_waitcnt lgkmcnt(" #n ")" ::: "memory")
#define BAR __builtin_amdgcn_s_barrier()
#define SCHED __builtin_amdgcn_sched_barrier(0)
  int tid = threadIdx.x; asm volatile("" : "+v"(tid));
  const int wid = tid >> 6, lane = tid & 63, wr = wid >> 2, wc = wid & 3, fr = lane & 15, fq = lane >> 4;
  const int nM = M / BM, nN = N / BM, nwg = nM * nN, nt = K / BK;
  unsigned voff[2];
#pragma unroll
  for (int i = 0; i < 2; ++i) { int R, C; stage_rc(tid * 16 + i * 8192, R, C); voff[i] = (unsigned)(R * K + C) * 2u; }
  const unsigned ldsw = (unsigned)__builtin_amdgcn_readfirstlane(wid) * 1024u;
  const int aoff = lds_byte(wr * 64 + fr, fq * 8), boff = lds_byte(wc * 32 + fr, fq * 8);
  const size_t kstep = (size_t)BK * 2, hstep = (size_t)HALF * K * 2;
#define TILE_COORDS(T, BR, BC) do { int wgid = (T); \
    { int q = nwg / NXCD, r = nwg % NXCD, xcd = wgid % NXCD, off = wgid / NXCD; wgid = (xcd < r ? xcd * (q + 1) : r * (q + 1) + (xcd - r) * q) + off; } \
    const int nig = WGM * nN, gid = wgid / nig, fm = gid * WGM, gsz = (nM - fm) < WGM ? (nM - fm) : WGM; \
    BR = (fm + ((wgid % nig) % gsz)) * BM; BC = ((wgid % nig) / gsz) * BM; } while (0)
  int tile = blockIdx.x;
  if (tile < nwg) {
    int brow, bcol;
    TILE_COORDS(tile, brow, bcol);
    const char* cA = (const char*)A + (size_t)brow * K * 2; const char* cB = (const char*)Bt + (size_t)bcol * K * 2;
    WAIT_V(0); WAIT_L(0);
    __syncthreads();
    STAGE(SB(0, 0), cB, voff); STAGE(SA(0, 0), cA, voff);
    STAGE(SB(0, 1), cB + hstep, voff); STAGE(SA(0, 1), cA + hstep, voff);
  for (;;) {
    f32x4 acc[2][2][4][2];
#pragma unroll
    for (int a = 0; a < 2; ++a)
#pragma unroll
      for (int b = 0; b < 2; ++b)
#pragma unroll
        for (int m = 0; m < 4; ++m)
#pragma unroll
          for (int n = 0; n < 2; ++n) acc[a][b][m][n] = (f32x4){0.f, 0.f, 0.f, 0.f};
    bf16x8 At[4][2], B0[2][2], B1[2][2];
    if (wr == 1) BAR;
    WAIT_V(4); BAR;
    STAGE(SB(1, 0), cB + (size_t)(1) * kstep, voff); STAGE(SA(1, 0), cA + (size_t)(1) * kstep, voff); STAGE(SB(1, 1), cB + hstep + (size_t)(1) * kstep, voff);
    WAIT_V(6); BAR;
    for (int t = 0; t < nt - 2; t += 2) {
      LDB(B0, 0, 0); SCHED; LDA(At, 0, 0); STAGE(SA(1, 1), cA + hstep + (size_t)(t + 1) * kstep, voff);
      WAIT_L(8); BAR; WAIT_L(0); MMA(0, 0, At, B0); BAR; SCHED;
      LDB(B1, 0, 1); STAGE(SB(0, 0), cB + (size_t)(t + 2) * kstep, voff);
      BAR; WAIT_L(0); MMA(0, 1, At, B1); BAR;
      LDA(At, 0, 1); STAGE(SA(0, 0), cA + (size_t)(t + 2) * kstep, voff);
      BAR; WAIT_L(0); MMA(1, 0, At, B0); BAR; SCHED;
      STAGE(SB(0, 1), cB + hstep + (size_t)(t + 2) * kstep, voff);
      WAIT_V(6); BAR; MMA(1, 1, At, B1); BAR;
      LDB(B0, 1, 0); SCHED; LDA(At, 1, 0); STAGE(SA(0, 1), cA + hstep + (size_t)(t + 2) * kstep, voff);
      WAIT_L(8); BAR; WAIT_L(0); MMA(0, 0, At, B0); BAR; SCHED;
      LDB(B1, 1, 1); STAGE(SB(1, 0), cB + (size_t)(t + 3) * kstep, voff);
      BAR; WAIT_L(0); MMA(0, 1, At, B1); BAR;
      LDA(At, 1, 1); STAGE(SA(1, 0), cA + (size_t)(t + 3) * kstep, voff);
      BAR; WAIT_L(0); MMA(1, 0, At, B0); BAR; SCHED;
      STAGE(SB(1, 1), cB + hstep + (size_t)(t + 3) * kstep, voff);
      WAIT_V(6); BAR; MMA(1, 1, At, B1); BAR;
    }
    { LDB(B0, 0, 0); LDA(At, 0, 0); STAGE(SA(1, 1), cA + hstep + (size_t)(nt - 1) * kstep, voff);
      BAR; WAIT_L(0); MMA(0, 0, At, B0); BAR;
      LDB(B1, 0, 1); BAR; WAIT_L(0); MMA(0, 1, At, B1); BAR;
      LDA(At, 0, 1); WAIT_V(4); BAR; WAIT_L(0); MMA(1, 0, At, B0); MMA(1, 1, At, B1); BAR; }
    { LDB(B0, 1, 0); LDA(At, 1, 0); WAIT_V(2); BAR; WAIT_L(0); MMA(0, 0, At, B0); BAR;
      LDB(B1, 1, 1); WAIT_V(0); BAR; WAIT_L(0); MMA(0, 1, At, B1); BAR;
      LDA(At, 1, 1); BAR; WAIT_L(0); MMA(1, 0, At, B0); MMA(1, 1, At, B1); BAR; }
    if (wr == 0) BAR;
    const int ntile = tile + (int)gridDim.x; const bool more = ntile < nwg;
    int nbrow = 0, nbcol = 0;
    if (more) {
      TILE_COORDS(ntile, nbrow, nbcol);
      cA = (const char*)A + (size_t)nbrow * K * 2; cB = (const char*)Bt + (size_t)nbcol * K * 2;
      STAGE(SB(0, 0), cB, voff); STAGE(SA(0, 0), cA, voff);
      STAGE(SB(0, 1), cB + hstep, voff); STAGE(SA(0, 1), cA + hstep, voff);
    }
#pragma unroll
    for (int ai = 0; ai < 2; ++ai)
#pragma unroll
      for (int bj = 0; bj < 2; ++bj) epi(acc[ai][bj], brow + ai * HALF + wr * 64, bcol + bj * HALF + wc * 32, fr, fq);
    if (!more) break;
    tile = ntile; brow = nbrow; bcol = nbcol;
  }
  }
#undef TILE_COORDS
#undef SA
#undef SB
#undef STAGE
#undef LDA
#undef LDB
#undef MMA
#undef WAIT_V
#undef WAIT_L
#undef BAR
#undef SCHED
}

struct EpiGU256 { bf16_t* H;
  __device__ __forceinline__ void operator()(const f32x4 (&acc)[4][2], int row0, int col0, int fr, int fq) const {
    const int hb = col0 >> 1;
#pragma unroll
    for (int m = 0; m < 4; ++m) { const size_t row = row0 + m * 16 + fr; const f32x4 gt = acc[m][0], up = acc[m][1];
      *(s16x4*)(H + row * DFF + hb + 4 * fq) = pack4(siluf(gt[0]) * up[0], siluf(gt[1]) * up[1], siluf(gt[2]) * up[2], siluf(gt[3]) * up[3]); }
  } };
struct EpiResid256 { const float* srcL; const float* srcC; float* dstL; float* dstC; const float* mod; int gi; float fac;
  __device__ __forceinline__ void operator()(const f32x4 (&acc)[4][2], int row0, int col0, int fr, int fq) const {
#pragma unroll
    for (int m = 0; m < 4; ++m) { const int row = row0 + m * 16 + fr;
      const float* sp = row < NLAT ? srcL + (size_t)row * DM : srcC + (size_t)(row - NLAT) * DM;
      float* dp = row < NLAT ? dstL + (size_t)row * DM : dstC + (size_t)(row - NLAT) * DM;
      const float* mp = mod + (row < NLAT ? (row >> 12) : 8) * 9216 + gi * 1024;
#pragma unroll
      for (int n = 0; n < 2; ++n) { const int col = col0 + n * 16 + 4 * fq; const f32x4 gt = *(const f32x4*)(mp + col); const f32x4 sv = *(const f32x4*)(sp + col); *(f32x4*)(dp + col) = sv + (gt * fac) * acc[m][n]; } }
  } };
struct EpiInproj256 { bf16_t* U; bf16_t* QKVraw;
  __device__ __forceinline__ void operator()(const f32x4 (&acc)[4][2], int row0, int col0, int fr, int fq) const {
    bf16_t* base; int ld, cb;
    if (col0 < 512) { base = U; ld = UW; cb = col0; } else if (col0 < 1280) { base = QKVraw; ld = 768; cb = col0 - 512; } else { base = U; ld = UW; cb = col0 - 768; }
#pragma unroll
    for (int m = 0; m < 4; ++m) { const size_t row = row0 + m * 16 + fr;
#pragma unroll
      for (int n = 0; n < 2; ++n) *(s16x4*)(base + row * ld + cb + n * 16 + 4 * fq) = pack4(acc[m][n][0], acc[m][n][1], acc[m][n][2], acc[m][n][3]); }
  } };
__global__ void __launch_bounds__(512, 2) fwd_megakernel(Params p) {
  cg::grid_group grid = cg::this_grid();
  unsigned char* lds = (unsigned char*)dyn_shm + __builtin_amdgcn_readfirstlane((int)(raw_tid() >> 8)) * 65536;
  __shared__ int s_item;
  __shared__ u32x4 xb_words;
  if (raw_tid() == 0) xb_words = (u32x4){0u, 0u, 0u, 0u};
  __syncthreads();
  const XcdBarrier xb = xcd_barrier_post(p.bar, (volatile LAS unsigned*)&xb_words);
  mod_partial(p, (float*)lds);
  conv_weights(p, 0, (float*)lds);
  grid.sync();
  mod_final(p);
  xcd_barrier(xb);
  for (int layer = 0; layer < 2; ++layer) {
    const bool need_ctx = layer == 0;
    const float* mod = p.MOD + layer * 82944;
    const float* srcL = layer == 0 ? p.x : p.out; const float* srcC = layer == 0 ? p.ctx : p.Xc;
    if (layer == 1) conv_weights(p, 1, (float*)lds);
    norm_phase<0>(srcL, srcC, NTOK, p.norm1_g + layer * DM, mod, 0, 1, p.XN, nullptr);
    xcd_barrier(xb);
    gemm256_phase(p.XN, p.W + OW_GU1, NTOK, 2 * DFF, DM, EpiGU256{p.H});
    xcd_barrier(xb);
    gemm256_phase(p.H, p.W + OW_D1, NLAT, DM, DFF, EpiResid256{srcL, srcC, p.out, p.Xc, mod, 2, 0.5f});
    gemm64_ctx(p.H + (size_t)NLAT * DFF, DFF, p.W + OW_D1, DFF, DFF, srcC, p.Xc, mod, 2, 0.5f, lds);
    xcd_barrier(xb);
    norm_phase<0>(p.out, p.Xc, NTOK, p.norm2_g + layer * DM, mod, 3, 4, p.XN, nullptr);
    xcd_barrier(xb);
    gemm256_phase(p.XN, p.W + OW_IN, NTOK, 2816, DM, EpiInproj256{p.U, p.QKVraw});
    xcd_barrier(xb);
    prep_phase(p, layer);
    xcd_barrier(xb);
    gemm_phase(p.U + 784, UW, p.W + OW_UQ, 256, NTOK, 384, 256, EpiPlain{p.QM, 384}, lds);
    gemm_phase(p.U + 1040, UW, p.W + OW_UKV, 128, NTOK, 512, 128, EpiKVM{p.KVM, p.kmx + layer * 32}, lds);
    dn_chunk(p, lds);
    xcd_barrier(xb);
    mixer_phase(p, layer, need_ctx, lds, &s_item);
    xcd_barrier(xb);
    const int M2 = need_ctx ? NTOK : NLAT;
    gated_out(p, layer, M2);
    xcd_barrier(xb);
    gemm256_phase(p.XN, p.W + OW_OUT, NLAT, DM, DM, EpiResid256{p.out, p.Xc, p.out, p.Xc, mod, 5, 1.0f});
    if (need_ctx) gemm64_ctx(p.XN + (size_t)NLAT * DM, DM, p.W + OW_OUT, DM, DM, p.Xc, p.Xc, mod, 5, 1.0f, lds);
    xcd_barrier(xb);
    norm_phase<0>(p.out, p.Xc, M2, p.norm3_g + layer * DM, mod, 6, 7, p.XN, nullptr);
    xcd_barrier(xb);
    gemm256_phase(p.XN, p.W + OW_GU2, M2, 2 * DFF, DM, EpiGU256{p.H});
    xcd_barrier(xb);
    gemm256_phase(p.H, p.W + OW_D2, NLAT, DM, DFF, EpiResid256{p.out, p.Xc, p.out, p.Xc, mod, 8, 0.5f});
    if (need_ctx) gemm64_ctx(p.H + (size_t)NLAT * DFF, DFF, p.W + OW_D2, DFF, DFF, p.Xc, p.Xc, mod, 8, 0.5f, lds);
    xcd_barrier(xb);
  }
  norm_phase<1>(p.out, p.Xc, NLAT, p.final_norm_g, nullptr, 0, 0, nullptr, p.out);
}

extern "C" void kernel_launch(void* const* d_in, const int* in_sizes, int n_in, void* d_out, int out_size, void* d_ws, size_t ws_size, hipStream_t stream) {
  static int grid_blocks = 0;
  if (!grid_blocks) {
    int dev = 0, cus = 0, per_cu = 0;
    hipGetDevice(&dev);
    hipDeviceGetAttribute(&cus, hipDeviceAttributeMultiprocessorCount, dev);
    hipFuncSetAttribute((const void*)fwd_megakernel, hipFuncAttributeMaxDynamicSharedMemorySize, 131072);
    hipOccupancyMaxActiveBlocksPerMultiprocessor(&per_cu, fwd_megakernel, 512, 131072);
    if (per_cu > 1) per_cu = 1;
    if (per_cu < 1) per_cu = 1;
    grid_blocks = cus * per_cu;
  }
  Params p; memset(&p, 0, sizeof(p));
  const float** pin = (const float**)&p;
  for (int i = 0; i < 28; ++i) pin[i] = (const float*)d_in[i];
  p.out = (float*)d_out;
  unsigned char* ws = (unsigned char*)d_ws; size_t off = 0;
  auto take = [&](size_t bytes) { unsigned char* q = ws + off; off += (bytes + 255) & ~(size_t)255; return q; };
  p.Xc = (float*)take((size_t)NCTX * DM * 4);
  p.XN = (bf16_t*)take((size_t)NTOK * DM * 2);
  p.W = (bf16_t*)take((size_t)W_ELEMS * 2);
  p.MOD = (float*)take((size_t)165888 * 4);
  p.bar = (unsigned*)take(16384);
  p.cnt = p.bar + 3584;
  p.kmx = p.bar + 3584 + 128;
  unsigned char* big = ws + off;
  p.H = (bf16_t*)big;
  p.PART = (float*)big;
  size_t boff = 0;
  auto takeb = [&](size_t bytes) { unsigned char* q = big + boff; boff += (bytes + 255) & ~(size_t)255; return q; };
  p.U = (bf16_t*)takeb((size_t)NTOK * UW * 2);
  p.QM = (bf16_t*)takeb((size_t)NTOK * 384 * 2);
  p.KVM = (bf16_t*)takeb((size_t)NTOK * 512 * 2);
  p.QKVd = (bf16_t*)takeb((size_t)NTOK * 768 * 2);
  p.DNW = (bf16_t*)takeb((size_t)4352 * 4096 * 2);
  p.QKVraw = p.DNW;
  p.DNU = (bf16_t*)takeb((size_t)4352 * 4096 * 2);
  p.DNI = (bf16_t*)takeb((size_t)4352 * 4096 * 2);
  p.DGC = (float*)takeb((size_t)4352 * 64 * 4);
  p.OF = (bf16_t*)takeb((size_t)NTOK * 256 * 2);
  p.OB = (bf16_t*)takeb((size_t)NTOK * 256 * 2);
  p.GB = (float*)takeb((size_t)NTOK * 16 * 4);
  size_t hbytes = (size_t)NTOK * DFF * 2;
  size_t need = off + (boff > hbytes ? boff : hbytes);
  if (need > ws_size) { fprintf(stderr, "workspace too small: need %zu have %zu\n", need, ws_size); return; }
  hipMemsetAsync(p.bar, 0, 16384, stream);
  void* args[] = {&p};
  hipError_t e = hipLaunchCooperativeKernel((void*)fwd_megakernel, dim3(grid_blocks), dim3(512), args, 131072, stream);
  if (e != hipSuccess) fprintf(stderr, "cooperative launch failed: %s (grid %d)\n", hipGetErrorString(e), grid_blocks);
}
```

```cpp
#include <hip/hip_runtime.h>
#include <hip/hip_cooperative_groups.h>
#include <cstdint>
#include <cstring>
#include <cstdio>
namespace cg = cooperative_groups;

typedef unsigned short bf16_t;
typedef short bf16x8 __attribute__((ext_vector_type(8)));
typedef short s16x4 __attribute__((ext_vector_type(4)));
typedef float f32x4 __attribute__((ext_vector_type(4)));
typedef unsigned u32x4 __attribute__((ext_vector_type(4)));

__device__ __forceinline__ int raw_tid() { int t = threadIdx.x; asm volatile("" : "+v"(t)); return t; }
#define NLAT 32768
#define NCTX 2048
#define NTOK 34816
#define DM 1024
#define DFF 2816
#define UW 2048
#define EPSF 1e-6f
#define LDS_BYTES 53248

struct Params {
  const float *x, *c, *ctx, *c_ctx, *ada_w, *ada_b, *norm1_g, *ffn1_wg, *ffn1_wu, *ffn1_wd, *norm2_g, *w_in,
      *swa_sink, *dn_conv_w, *dn_a_log, *dn_dt_bias, *dn_norm_g, *mla_q_norm_g, *mla_w_uq, *mla_kv_norm_g,
      *mla_w_ukv, *na_rpb, *w_out, *norm3_g, *ffn2_wg, *ffn2_wu, *ffn2_wd, *final_norm_g;
  float* out;
  float* Xc; bf16_t* XN; bf16_t* W; float* MOD; unsigned* cnt; unsigned* bar; unsigned* kmx;
  bf16_t* H; bf16_t* U; bf16_t* QM; bf16_t* KVM; bf16_t* QKVd; bf16_t* QKVraw; bf16_t* DNW; bf16_t* DNU; bf16_t* DNI;
  float* DGC; bf16_t* OF; bf16_t* OB; float* GB; float* PART;
};

#define OW_GU1 0
#define OW_D1 5767168
#define OW_IN 8650752
#define OW_UQ 11534336
#define OW_UKV 11632640
#define OW_OUT 11698176
#define OW_GU2 12746752
#define OW_D2 18513920
#define W_ELEMS 21397504

__device__ __forceinline__ bf16_t f2bf(float f) { unsigned u = __float_as_uint(f); u += 0x7fffu + ((u >> 16) & 1u); return (bf16_t)(u >> 16); }
__device__ __forceinline__ float bf2f(bf16_t h) { return __uint_as_float(((unsigned)h) << 16); }
typedef unsigned u32x2 __attribute__((ext_vector_type(2)));
typedef float f32x2 __attribute__((ext_vector_type(2)));
typedef __bf16 bf16x2_t __attribute__((ext_vector_type(2)));
__device__ __forceinline__ unsigned cvt_pk_bf16(float lo, float hi) { const f32x2 v = {lo, hi}; return __builtin_bit_cast(unsigned, __builtin_convertvector(v, bf16x2_t)); }
__device__ __forceinline__ s16x4 pack4(float a, float b, float c, float d) { u32x2 r; r[0] = cvt_pk_bf16(a, b); r[1] = cvt_pk_bf16(c, d); return __builtin_bit_cast(s16x4, r); }
__device__ __forceinline__ float siluf(float v) { return v * __builtin_amdgcn_rcpf(1.f + __expf(-v)); }
__device__ __forceinline__ float wave_sum(float v) {
#pragma unroll
  for (int o = 32; o >= 1; o >>= 1) v += __shfl_xor(v, o);
  return v;
}
__device__ __forceinline__ int vb_() { int v = __builtin_amdgcn_readfirstlane((int)(blockIdx.x * 2 + (raw_tid() >> 8))); asm volatile("" : "+s"(v)); return v; }
__device__ __forceinline__ int nvb_() { int v = (int)(gridDim.x * 2); asm volatile("" : "+s"(v)); return v; }
#define VB vb_()
#define NVB nvb_()
__device__ __forceinline__ int opaque_tid() { return raw_tid() & 255; }
__device__ __forceinline__ void fast_sincos(float x, float& sn, float& cs) { sn = __sinf(x); cs = __cosf(x); }
#define MFMA(a, b, c) __builtin_amdgcn_mfma_f32_16x16x32_bf16((a), (b), (c), 0, 0, 0)


#define XB_TMO      128
#define XB_XCNT(j)  (256  + 64 * (j))
#define XB_XSUB(j)  (1280 + 64 * (j))
#define XB_XGEN(j)  (2304 + 64 * (j))
#define XB_TOP      3328
#define XB_TOPGEN   3392
#define XCD_BAR_WORDS 3456
#define XB_SPIN_CAP (1u << 22)
#define LAS __attribute__((address_space(3)))
__device__ __forceinline__ unsigned xb_ld(unsigned* p)              { return __hip_atomic_load(p, __ATOMIC_RELAXED, __HIP_MEMORY_SCOPE_AGENT); }
__device__ __forceinline__ unsigned xb_add(unsigned* p, unsigned v) { return __hip_atomic_fetch_add(p, v, __ATOMIC_RELAXED, __HIP_MEMORY_SCOPE_AGENT); }
__device__ __forceinline__ unsigned xb_xcc_id() { return (unsigned)__builtin_amdgcn_s_getreg((3 << 11) | 20) & 0xFu; }
#define XB_SPIN(cond, bar) do { unsigned _sp = 0; while (cond) { __builtin_amdgcn_s_sleep(1); \
    if ((++_sp & 255u) == 0u) { if (xb_ld(&(bar)[XB_TMO])) break; if (_sp > XB_SPIN_CAP) { atomicAdd(&(bar)[XB_TMO], 1u); break; } } } } while (0)
struct XcdBarrier { unsigned* bar; unsigned x; volatile LAS unsigned* st; };
__device__ __forceinline__ XcdBarrier xcd_barrier_post(unsigned* bar, volatile LAS unsigned* st) {
    XcdBarrier b; b.bar = bar; b.x = xb_xcc_id(); b.st = st;
    if (raw_tid() == 0) (void)xb_add(&bar[XB_XCNT(b.x)], 1u);
    return b;
}
__device__ __forceinline__ void xcd_barrier_complete(unsigned* bar, unsigned x, unsigned& nloc, unsigned& nx) {
    const unsigned G = gridDim.x * gridDim.y * gridDim.z;
    unsigned sum, cnt, mine, sp = 0u;
    for (;;) {
        sum = 0u; cnt = 0u; mine = 0u;
#pragma unroll
        for (unsigned j = 0; j < 16; ++j) { const unsigned c = xb_ld(&bar[XB_XCNT(j)]); sum += c; cnt += (c > 0u) ? 1u : 0u; mine = (j == x) ? c : mine; }
        if (sum == G) break;
        __builtin_amdgcn_s_sleep(1);
        if ((++sp & 255u) == 0u) { if (xb_ld(&bar[XB_TMO])) break; if (sp > XB_SPIN_CAP) { atomicAdd(&bar[XB_TMO], 1u); break; } }
    }
    nloc = mine > 0u ? mine : 1u; nx = cnt > 0u ? cnt : 1u;
}
__device__ __forceinline__ void xcd_barrier(const XcdBarrier& b) {
    asm volatile("s_waitcnt vmcnt(0)" ::: "memory");
    __syncthreads();
    if (raw_tid() == 0) {
        unsigned* bar = b.bar; const unsigned bx = xb_xcc_id();
        __builtin_amdgcn_s_waitcnt(0);
        unsigned nloc = b.st[0], nx = b.st[1];
        if (nloc == 0u) { xcd_barrier_complete(bar, bx, nloc, nx); b.st[0] = nloc; b.st[1] = nx; }
        const unsigned old = xb_add(&bar[XB_XSUB(bx)], 1u);
        const unsigned gen = old / nloc;
        if (old + 1u == (gen + 1u) * nloc) {
            __builtin_amdgcn_fence(__ATOMIC_RELEASE, "agent");
            asm volatile("s_waitcnt vmcnt(0)" ::: "memory");
            const unsigned og = xb_add(&bar[XB_TOP], 1u);
            const unsigned tg = og / nx;
            if (og + 1u == (tg + 1u) * nx) xb_add(&bar[XB_TOPGEN], 1u);
            else XB_SPIN(xb_ld(&bar[XB_TOPGEN]) == tg, bar);
            __builtin_amdgcn_fence(__ATOMIC_ACQUIRE, "agent");
            xb_add(&bar[XB_XGEN(bx)], 1u);
            asm volatile("s_waitcnt vmcnt(0)" ::: "memory");
        } else {
            XB_SPIN(xb_ld(&bar[XB_XGEN(bx)]) == gen, bar);
            __builtin_amdgcn_fence(__ATOMIC_ACQUIRE, "agent");
            asm volatile("s_waitcnt vmcnt(0)" ::: "memory");
        }
    }
    __syncthreads();
}

__device__ __forceinline__ void conv_job(const float* __restrict__ src, int K, int N, bf16_t* __restrict__ dst, int ldd, int map, float* tl) {
  const int tid = opaque_tid();
  const int ntn = (N + 63) / 64, nt = (K / 64) * ntn;
  for (int t0 = VB; t0 < nt; t0 += NVB * 2) {
    __syncthreads();
    f32x4 v[2][4];
#pragma unroll
    for (int u = 0; u < 2; ++u) { const int t = t0 + u * NVB; const int k0 = (t / ntn) * 64, n0 = (t % ntn) * 64;
#pragma unroll
      for (int i = 0; i < 4; ++i) { const int id = tid + 256 * i, kk = id >> 4, n4 = (id & 15) * 4;
        v[u][i] = (f32x4){0.f, 0.f, 0.f, 0.f};
        if (t < nt && n0 + n4 < N) v[u][i] = *(const f32x4*)(src + (size_t)(k0 + kk) * N + n0 + n4); } }
#pragma unroll
    for (int u = 0; u < 2; ++u)
#pragma unroll
      for (int i = 0; i < 4; ++i) { const int id = tid + 256 * i, kk = id >> 4, n4 = (id & 15) * 4; float* tp = tl + u * 4160 + kk * 65 + n4;
        tp[0] = v[u][i][0]; tp[1] = v[u][i][1]; tp[2] = v[u][i][2]; tp[3] = v[u][i][3]; }
    __syncthreads();
#pragma unroll
    for (int u = 0; u < 2; ++u) { const int t = t0 + u * NVB; if (t >= nt) continue; const int k0 = (t / ntn) * 64, n0 = (t % ntn) * 64;
#pragma unroll
      for (int i = 0; i < 2; ++i) {
        const int id = tid + 256 * i, nn = id >> 3, kc = id & 7, n = n0 + nn;
        if (n < N) {
          int dr = n; if (map == 1) dr = (n >> 4) * 32 + (n & 15); else if (map == 2) dr = (n >> 4) * 32 + 16 + (n & 15);
          u32x4 o; const float* tp = tl + u * 4160;
#pragma unroll
          for (int e = 0; e < 4; ++e) o[e] = cvt_pk_bf16(tp[(kc * 8 + 2 * e) * 65 + nn], tp[(kc * 8 + 2 * e + 1) * 65 + nn]);
          *(u32x4*)(dst + (size_t)dr * ldd + k0 + kc * 8) = o;
        }
      } }
  }
}
__device__ __forceinline__ void conv_weights(const Params& p, int l, float* tl) {
  const size_t ff = (size_t)DM * DFF;
  conv_job(p.ffn1_wg + l * ff, DM, DFF, p.W + OW_GU1, DM, 1, tl);
  conv_job(p.ffn1_wu + l * ff, DM, DFF, p.W + OW_GU1, DM, 2, tl);
  conv_job(p.ffn1_wd + l * ff, DFF, DM, p.W + OW_D1, DFF, 0, tl);
  conv_job(p.w_in + (size_t)l * DM * 2736, DM, 2736, p.W + OW_IN, DM, 0, tl);
  conv_job(p.mla_w_uq + (size_t)l * 256 * 384, 256, 384, p.W + OW_UQ, 256, 0, tl);
  conv_job(p.mla_w_ukv + (size_t)l * 128 * 512, 128, 512, p.W + OW_UKV, 128, 0, tl);
  conv_job(p.w_out + (size_t)l * DM * DM, DM, DM, p.W + OW_OUT, DM, 0, tl);
  conv_job(p.ffn2_wg + l * ff, DM, DFF, p.W + OW_GU2, DM, 1, tl);
  conv_job(p.ffn2_wu + l * ff, DM, DFF, p.W + OW_GU2, DM, 2, tl);
  conv_job(p.ffn2_wd + l * ff, DFF, DM, p.W + OW_D2, DFF, 0, tl);
  for (int e = VB * 256 + opaque_tid(); e < 80 * DM; e += NVB * 256) p.W[OW_IN + (size_t)2736 * DM + e] = 0;
}

__device__ __forceinline__ void mod_partial(const Params& p, float* sl) {
  const int tid = opaque_tid();
  for (int it = VB; it < 504; it += NVB) {
    const int kc = it % 7, cb = (it / 7) % 36, l = it / 252;
    const int kbeg = kc == 6 ? 877 : kc * 147, kskip = kc == 6 ? 5 : 0;
    __syncthreads();
    for (int e = tid; e < 9 * 147; e += 256) { const int r = e / 147, kk = e - r * 147;
      const float v = r < 8 ? p.c[r * 1024 + kbeg + kk] : p.c_ctx[kbeg + kk]; sl[e] = kk < kskip ? 0.f : v / (1.f + expf(-v)); }
    __syncthreads();
    const int j = cb * 256 + tid;
    const float* w = p.ada_w + (size_t)l * 1024 * 9216 + (size_t)kbeg * 9216 + j;
    float acc[9];
#pragma unroll
    for (int r = 0; r < 9; ++r) acc[r] = 0.f;
#pragma unroll 16
    for (int kk = 0; kk < 147; ++kk) {
      float wv = w[(size_t)kk * 9216];
#pragma unroll
      for (int r = 0; r < 9; ++r) acc[r] += sl[r * 147 + kk] * wv;
    }
#pragma unroll
    for (int r = 0; r < 9; ++r) p.PART[(size_t)kc * 165888 + (size_t)(l * 9 + r) * 9216 + j] = acc[r];
  }
}
__device__ __forceinline__ void mod_final(const Params& p) {
  for (int e = VB * 256 + opaque_tid(); e < 165888; e += NVB * 256) {
    int l = e / 82944, j = e % 9216;
    float s = p.ada_b[l * 9216 + j];
#pragma unroll
    for (int kc = 0; kc < 7; ++kc) s += p.PART[(size_t)kc * 165888 + e];
    p.MOD[e] = s;
  }
}

template <int MODE>
__device__ __forceinline__ void norm_phase(const float* srcL, const float* srcC, int M, const float* g, const float* mod, int shift_i, int scale_i, bf16_t* XN, float* outp) {
  const int tid = opaque_tid(); const int lane = tid & 63, w = tid >> 6;
  for (int row0 = (VB * 4 + w) * 4; row0 < M; row0 += NVB * 16) {
    f32x4 v[4][4]; float ss[4];
#pragma unroll
    for (int k = 0; k < 4; ++k) {
      const int row = row0 + k;
      const float* src = row < NLAT ? srcL + (size_t)row * DM : srcC + (size_t)(row - NLAT) * DM;
#pragma unroll
      for (int i = 0; i < 4; ++i) v[k][i] = *(const f32x4*)(src + i * 256 + lane * 4);
    }
#pragma unroll
    for (int k = 0; k < 4; ++k) { float a = 0.f;
#pragma unroll
      for (int i = 0; i < 4; ++i) a += v[k][i][0] * v[k][i][0] + v[k][i][1] * v[k][i][1] + v[k][i][2] * v[k][i][2] + v[k][i][3] * v[k][i][3];
      ss[k] = wave_sum(a); }
#pragma unroll
    for (int k = 0; k < 4; ++k) {
      const int row = row0 + k;
      const float rs = rsqrtf(ss[k] * (1.f / 1024.f) + EPSF);
      const int mr = row < NLAT ? (row >> 12) : 8;
#pragma unroll
      for (int i = 0; i < 4; ++i) {
        const int col = i * 256 + lane * 4;
        const f32x4 gg = *(const f32x4*)(g + col);
        if (MODE == 0) {
          const f32x4 sc = *(const f32x4*)(mod + mr * 9216 + scale_i * 1024 + col);
          const f32x4 sh = *(const f32x4*)(mod + mr * 9216 + shift_i * 1024 + col);
          f32x4 y = (v[k][i] * rs * gg) * (sc + 1.f) + sh;
          *(s16x4*)(XN + (size_t)row * DM + col) = pack4(y[0], y[1], y[2], y[3]);
        } else {
          *(f32x4*)(outp + (size_t)row * DM + col) = v[k][i] * rs * gg;
        }
      }
    }
  }
}

struct EpiGU {
  bf16_t* H;
  __device__ __forceinline__ void operator()(const f32x4 (&acc)[4][4], int row0, int col0, int r, int gq) const {
    const int hb = col0 >> 1;
#pragma unroll
    for (int m = 0; m < 4; ++m) {
      const size_t row = row0 + m * 16 + r;
#pragma unroll
      for (int pz = 0; pz < 2; ++pz) {
        const f32x4 gt = acc[m][2 * pz], up = acc[m][2 * pz + 1];
        *(s16x4*)(H + row * DFF + hb + pz * 16 + 4 * gq) = pack4(siluf(gt[0]) * up[0], siluf(gt[1]) * up[1], siluf(gt[2]) * up[2], siluf(gt[3]) * up[3]);
      }
    }
  }
};
struct EpiResid {
  const float* srcL; const float* srcC; float* dstL; float* dstC; const float* mod; int gi; float fac;
  __device__ __forceinline__ void operator()(const f32x4 (&acc)[4][4], int row0, int col0, int r, int gq) const {
#pragma unroll
    for (int m = 0; m < 4; ++m) {
      const int row = row0 + m * 16 + r;
      const float* sp = row < NLAT ? srcL + (size_t)row * DM : srcC + (size_t)(row - NLAT) * DM;
      float* dp = row < NLAT ? dstL + (size_t)row * DM : dstC + (size_t)(row - NLAT) * DM;
      const float* mp = mod + (row < NLAT ? (row >> 12) : 8) * 9216 + gi * 1024;
#pragma unroll
      for (int n = 0; n < 4; ++n) {
        const int col = col0 + n * 16 + 4 * gq;
        const f32x4 gt = *(const f32x4*)(mp + col);
        const f32x4 s = *(const f32x4*)(sp + col);
        *(f32x4*)(dp + col) = s + (gt * fac) * acc[m][n];
      }
    }
  }
};
struct EpiInproj {
  bf16_t* U; bf16_t* QKVraw;
  __device__ __forceinline__ void operator()(const f32x4 (&acc)[4][4], int row0, int col0, int r, int gq) const {
    bf16_t* base; int ld, cb;
    if (col0 < 512) { base = U; ld = UW; cb = col0; }
    else if (col0 < 1280) { base = QKVraw; ld = 768; cb = col0 - 512; }
    else { base = U; ld = UW; cb = col0 - 768; }
#pragma unroll
    for (int m = 0; m < 4; ++m) {
      const size_t row = row0 + m * 16 + r;
#pragma unroll
      for (int n = 0; n < 4; ++n) *(s16x4*)(base + row * ld + cb + n * 16 + 4 * gq) = pack4(acc[m][n][0], acc[m][n][1], acc[m][n][2], acc[m][n][3]);
    }
  }
};
struct EpiKVM {
  bf16_t* C; unsigned* kn2;
  __device__ __forceinline__ void operator()(const f32x4 (&acc)[4][4], int row0, int col0, int r, int gq) const {
    const bool nope = (col0 & 64) == 0;
    float rmax = 0.f;
#pragma unroll
    for (int m = 0; m < 4; ++m) {
      const size_t row = row0 + m * 16 + r; float ss = 0.f;
#pragma unroll
      for (int n = 0; n < 4; ++n) {
        const s16x4 pk = pack4(acc[m][n][0], acc[m][n][1], acc[m][n][2], acc[m][n][3]);
        *(s16x4*)(C + row * 512 + col0 + n * 16 + 4 * gq) = pk;
#pragma unroll
        for (int j = 0; j < 4; ++j) { const float v = __uint_as_float(((unsigned)(unsigned short)pk[j]) << 16); ss += v * v; }
      }
      ss += __shfl_xor(ss, 16); ss += __shfl_xor(ss, 32);
      rmax = fmaxf(rmax, ss);
    }
    if (nope) {
#pragma unroll
      for (int o = 1; o < 16; o <<= 1) rmax = fmaxf(rmax, __shfl_xor(rmax, o));
      const int b = row0 < NLAT ? (row0 >> 12) : ((row0 - NLAT) >> 8);
      if (r == 0 && gq == 0) __hip_atomic_fetch_max(kn2 + b * 4 + (col0 >> 7), __float_as_uint(rmax), __ATOMIC_RELAXED, __HIP_MEMORY_SCOPE_AGENT);
    }
  }
};
struct EpiPlain {
  bf16_t* C; int ldc;
  __device__ __forceinline__ void operator()(const f32x4 (&acc)[4][4], int row0, int col0, int r, int gq) const {
#pragma unroll
    for (int m = 0; m < 4; ++m) {
      const size_t row = row0 + m * 16 + r;
#pragma unroll
      for (int n = 0; n < 4; ++n) *(s16x4*)(C + row * ldc + col0 + n * 16 + 4 * gq) = pack4(acc[m][n][0], acc[m][n][1], acc[m][n][2], acc[m][n][3]);
    }
  }
};

template <class Epi>
__device__ __forceinline__ void gemm_phase(const bf16_t* __restrict__ A, int lda, const bf16_t* __restrict__ Bt, int ldb, int M, int N, int K, const Epi& epi, unsigned char* lds) {
  bf16_t* As = (bf16_t*)lds; bf16_t* Bs = As + 128 * 72;
  const int tid = opaque_tid(), lane = tid & 63, w = tid >> 6, wr = w >> 1, wc = w & 1, r = lane & 15, gq = lane >> 4;
  const int ntn = N / 128, nt = (M / 128) * ntn, nk = K / 64;
  for (int tile = VB; tile < nt; tile += NVB) {
    const int pm = tile / ntn, pn = tile - pm * ntn;
    const bf16_t* Ag = A + (size_t)(pm * 128) * lda; const bf16_t* Bg = Bt + (size_t)(pn * 128) * ldb;
    f32x4 acc[4][4];
#pragma unroll
    for (int m = 0; m < 4; ++m)
#pragma unroll
      for (int n = 0; n < 4; ++n) acc[m][n] = (f32x4){0.f, 0.f, 0.f, 0.f};
    u32x4 ra[4], rb[4];
#pragma unroll
    for (int i = 0; i < 4; ++i) { const int id = tid + 256 * i, row = id >> 3, kc = id & 7;
      ra[i] = *(const u32x4*)(Ag + (size_t)row * lda + kc * 8); rb[i] = *(const u32x4*)(Bg + (size_t)row * ldb + kc * 8); }
    for (int kt = 0; kt < nk; ++kt) {
      __syncthreads();
#pragma unroll
      for (int i = 0; i < 4; ++i) { const int id = tid + 256 * i, row = id >> 3, kc = id & 7;
        *(u32x4*)(As + row * 72 + kc * 8) = ra[i]; *(u32x4*)(Bs + row * 72 + kc * 8) = rb[i]; }
      __syncthreads();
      if (kt + 1 < nk) {
        const int k0 = (kt + 1) * 64;
#pragma unroll
        for (int i = 0; i < 4; ++i) { const int id = tid + 256 * i, row = id >> 3, kc = id & 7;
          ra[i] = *(const u32x4*)(Ag + (size_t)row * lda + k0 + kc * 8); rb[i] = *(const u32x4*)(Bg + (size_t)row * ldb + k0 + kc * 8); }
      }
#pragma unroll
      for (int ks = 0; ks < 2; ++ks) {
        bf16x8 af[4], bfr[4];
#pragma unroll
        for (int m = 0; m < 4; ++m) af[m] = *(const bf16x8*)(As + (wr * 64 + m * 16 + r) * 72 + ks * 32 + gq * 8);
#pragma unroll
        for (int n = 0; n < 4; ++n) bfr[n] = *(const bf16x8*)(Bs + (wc * 64 + n * 16 + r) * 72 + ks * 32 + gq * 8);
#pragma unroll
        for (int m = 0; m < 4; ++m)
#pragma unroll
          for (int n = 0; n < 4; ++n) acc[m][n] = MFMA(bfr[n], af[m], acc[m][n]);
      }
    }
    epi(acc, pm * 128 + wr * 64, pn * 128 + wc * 64, r, gq);
  }
}

__device__ __forceinline__ void prep_phase(const Params& p, int layer) {
  const int tid = opaque_tid(); const int lane = tid & 63, w = tid >> 6;
  const float* __restrict__ convw = p.dn_conv_w + layer * 3 * 768;
  float cw[12][3];
#pragma unroll
  for (int hh = 0; hh < 12; ++hh)
#pragma unroll
    for (int j = 0; j < 3; ++j) cw[hh][j] = convw[j * 768 + hh * 64 + lane];
  const int k_head = lane >> 5, k_pp = lane & 31, k_half = k_pp >> 4, k_i = k_pp & 15;
  const int k_i1 = 256 + k_head * 64 + k_half * 32 + k_i, k_i2 = k_i1 + 16;
  const float k_inv = exp2f(-(float)k_i * (13.287712379549449f / 16.f));
  const int r_half = (lane >> 3) & 1, r_i = lane & 7; const int r_i1 = 1168 + r_half * 16 + r_i, r_i2 = r_i1 + 8;
  const float r_inv = exp2f(-(float)r_i * (13.287712379549449f / 8.f));
  f32x4 gq4 = *(const f32x4*)(p.mla_q_norm_g + layer * 256 + lane * 4);
  const float gk0 = p.mla_kv_norm_g[layer * 128 + lane * 2], gk1 = p.mla_kv_norm_g[layer * 128 + lane * 2 + 1];
  const float dtb = p.dn_dt_bias[layer * 8 + (lane & 7)], alog = -expf(p.dn_a_log[layer * 8 + (lane & 7)]);
  float wkr = 0.f;
  struct PrepIn { bf16_t kt1, kt2, rt1, rt2, ab; u32x2 cq2; unsigned ckv1; bf16_t x0[12], x1[12], x2[12]; };
  auto load_tok = [&](int tok, PrepIn& in) {
    const bool isctx = tok >= NLAT;
    const bf16_t* __restrict__ u = p.U + (size_t)tok * UW;
    const int pos = isctx ? ((tok - NLAT) & 255) : (tok & 4095); const int len = isctx ? 256 : 4096;
    const bool hp = pos > 0, hn = pos < len - 1;
    const bf16_t* __restrict__ r1 = p.QKVraw + (size_t)tok * 768;
    in.kt1 = u[k_i1]; in.kt2 = u[k_i2]; in.rt1 = u[r_i1]; in.rt2 = u[r_i2];
    in.cq2 = *(const u32x2*)(u + 784 + lane * 4);
    in.ckv1 = *(const unsigned*)(u + 1040 + lane * 2);
    in.ab = u[768 + (lane & 15)];
#pragma unroll
    for (int hh = 0; hh < 12; ++hh) { const int col = hh * 64 + lane; in.x0[hh] = hp ? r1[col - 768] : (bf16_t)0; in.x1[hh] = r1[col]; in.x2[hh] = hn ? r1[col + 768] : (bf16_t)0; }
  };
  auto comp_tok = [&](int tok, const PrepIn& in) {
    const bool isctx = tok >= NLAT;
    bf16_t* __restrict__ u = p.U + (size_t)tok * UW;
    const bf16_t kt1 = in.kt1, kt2 = in.kt2, rt1 = in.rt1, rt2 = in.rt2, ab = in.ab; const u32x2 cq2 = in.cq2; const unsigned ckv1 = in.ckv1;
    const bf16_t* x0 = in.x0; const bf16_t* x1 = in.x1; const bf16_t* x2 = in.x2;
    float kr2 = 0.f;
    if (!isctx) {
      const int sq = tok & 4095; const float prow = (float)(sq >> 6), pcol = (float)(sq & 63);
      { float sn, cs; fast_sincos((k_half ? pcol : prow) * k_inv, sn, cs); const float t1 = bf2f(kt1), t2 = bf2f(kt2);
        u[k_i1] = f2bf(t1 * cs - t2 * sn); u[k_i2] = f2bf(t2 * cs + t1 * sn); }
      if (lane < 16) { float sn, cs; fast_sincos((r_half ? pcol : prow) * r_inv, sn, cs); const float t1 = bf2f(rt1), t2 = bf2f(rt2);
        const bf16_t b1 = f2bf(t1 * cs - t2 * sn), b2 = f2bf(t2 * cs + t1 * sn);
        u[r_i1] = b1; u[r_i2] = b2; kr2 = bf2f(b1) * bf2f(b1) + bf2f(b2) * bf2f(b2); }
    } else if (lane < 16) { kr2 = bf2f(rt1) * bf2f(rt1) + bf2f(rt2) * bf2f(rt2); }
    wkr = fmaxf(wkr, wave_sum(kr2));
    {
      float v[4] = {__uint_as_float(cq2[0] << 16), __uint_as_float(cq2[0] & 0xffff0000u), __uint_as_float(cq2[1] << 16), __uint_as_float(cq2[1] & 0xffff0000u)};
      float ss = v[0] * v[0] + v[1] * v[1] + v[2] * v[2] + v[3] * v[3];
      ss = wave_sum(ss); float rs = rsqrtf(ss * (1.f / 256.f) + EPSF);
      *(s16x4*)(u + 784 + lane * 4) = pack4(v[0] * rs * gq4[0], v[1] * rs * gq4[1], v[2] * rs * gq4[2], v[3] * rs * gq4[3]);
      const float c0 = __uint_as_float(ckv1 << 16), c1 = __uint_as_float(ckv1 & 0xffff0000u);
      ss = wave_sum(c0 * c0 + c1 * c1); rs = rsqrtf(ss * (1.f / 128.f) + EPSF);
      *(unsigned*)(u + 1040 + lane * 2) = cvt_pk_bf16(c0 * rs * gk0, c1 * rs * gk1);
    }
    {
      bf16_t* __restrict__ od = p.QKVd + (size_t)tok * 768;
#pragma unroll
      for (int hh = 0; hh < 12; ++hh) {
        float hv = cw[hh][0] * bf2f(x0[hh]) + cw[hh][1] * bf2f(x1[hh]) + cw[hh][2] * bf2f(x2[hh]);
        hv = hv * __builtin_amdgcn_rcpf(1.f + __expf(-hv));
        if (hh < 8) { float ss = wave_sum(hv * hv); hv *= rsqrtf(ss + EPSF); if (hh < 4) hv *= 0.125f; }
        od[hh * 64 + lane] = f2bf(hv);
      }
      const float av = bf2f(ab);
      if (lane < 8) {
        const float xx = av + dtb;
        const float ee = __expf(xx);
        const float sp = xx > 15.f ? xx : (ee < 0.03f ? ee * (1.f - ee * (0.5f - ee * (0.33333334f - 0.25f * ee))) : __logf(1.f + ee));
        p.GB[(size_t)tok * 16 + lane] = alog * sp;
      } else if (lane < 16) {
        p.GB[(size_t)tok * 16 + lane] = 1.f / (1.f + __expf(-av));
      }
    }
  };
  for (int tok = VB * 4 + w; tok < NTOK; tok += NVB * 12) {
    const int tokB = tok + NVB * 4, tokC = tok + NVB * 8; const bool hasB = tokB < NTOK, hasC = tokC < NTOK;
    PrepIn ia, ib, ic;
    load_tok(tok, ia);
    if (hasB) load_tok(tokB, ib);
    if (hasC) load_tok(tokC, ic);
    comp_tok(tok, ia);
    if (hasB) comp_tok(tokB, ib);
    if (hasC) comp_tok(tokC, ic);
  }
  if (lane == 0) __hip_atomic_fetch_max(p.kmx + 64 + layer, __float_as_uint(wkr), __ATOMIC_RELAXED, __HIP_MEMORY_SCOPE_AGENT);
}

__device__ __forceinline__ void dn_chunk(const Params& p, unsigned char* lds) {
  bf16_t* Ks = (bf16_t*)lds; bf16_t* Qs = Ks + 64 * 72; bf16_t* Vs = Qs + 64 * 72;
  float* LsF = (float*)(Vs + 64 * 72); float* LsB = LsF + 4096; float* gcs = LsB + 4096; float* betas = gcs + 128; float* bexp = betas + 128;
  int tid = opaque_tid(); int lane = tid & 63, w = tid >> 6, r = lane & 15, g = lane >> 4;
  u32x4 pq[2], pk[2], pv[2]; float pg = 0.f, pb = 0.f;
#define DNC_DECODE(IT, BH, H, TOKBASE, STF, STB) const int BH = (IT) / 68, H = BH & 3; int TOKBASE, STF, STB; { const int _n = (IT) % 68, _b = BH >> 2; \
    if (_n < 4) { TOKBASE = NLAT + _b * 256 + _n * 64; STF = _n; STB = 3 - _n; } else { TOKBASE = _b * 4096 + (_n - 4) * 64; STF = _n; STB = 4 + 63 - (_n - 4); } }
#define DNC_ISSUE(IT) do { DNC_DECODE(IT, _bh, _h, _tb, _sf, _sb) \
    _Pragma("unroll") for (int i = 0; i < 2; ++i) { const int id = tid + 256 * i, row = id >> 3, kc = id & 7; \
      const bf16_t* src = p.QKVd + (size_t)(_tb + row) * 768 + _h * 64 + kc * 8; \
      pq[i] = *(const u32x4*)src; pk[i] = *(const u32x4*)(src + 256); pv[i] = *(const u32x4*)(src + 512); } \
    if (w < 2) { const int tok = _tb + (w ? 63 - lane : lane); pg = p.GB[(size_t)tok * 16 + w * 4 + _h]; pb = p.GB[(size_t)tok * 16 + 8 + w * 4 + _h]; } } while (0)
  const int it0 = NVB - 1 - VB;
  if (it0 < 2176) DNC_ISSUE(it0);
  for (int it = it0; it < 2176; it += NVB) {
    asm volatile("" : "+v"(tid)); lane = tid & 63; w = tid >> 6; r = lane & 15; g = lane >> 4;
    DNC_DECODE(it, bh, h, tokbase, stf, stb)
    const size_t idxF = (size_t)(bh * 2) * 68 + stf, idxB = (size_t)(bh * 2 + 1) * 68 + stb;
    __syncthreads();
#pragma unroll
    for (int i = 0; i < 2; ++i) {
      const int id = tid + 256 * i, row = id >> 3, kc = id & 7;
      *(u32x4*)(Qs + row * 72 + kc * 8) = pq[i];
      *(u32x4*)(Ks + row * 72 + kc * 8) = pk[i];
      *(u32x4*)(Vs + row * 72 + kc * 8) = pv[i];
    }
    if (w < 2) {
      float gv = pg; const float bv = pb;
#pragma unroll
      for (int o = 1; o < 64; o <<= 1) { float tt = __shfl_up(gv, o); if (lane >= o) gv += tt; }
      gcs[w * 64 + lane] = gv; betas[w * 64 + lane] = bv; bexp[w * 64 + lane] = bv * expf(gv); p.DGC[(w ? idxB : idxF) * 64 + lane] = gv;
    }
    __syncthreads();
    {
      const int a = 16 * w + r, cb = 63 - a;
      const float gF = gcs[a], bF = betas[a], gB = gcs[64 + cb], bB = betas[64 + cb];
      bf16x8 aK[2], aQ[2];
#pragma unroll
      for (int ks = 0; ks < 2; ++ks) { aK[ks] = *(const bf16x8*)(Ks + a * 72 + ks * 32 + g * 8); aQ[ks] = *(const bf16x8*)(Qs + a * 72 + ks * 32 + g * 8); }
#pragma unroll
      for (int jb = 0; jb < 4; ++jb) {
        f32x4 accK = {0.f, 0.f, 0.f, 0.f}, accQ = {0.f, 0.f, 0.f, 0.f};
#pragma unroll
        for (int ks = 0; ks < 2; ++ks) { const bf16x8 bj = *(const bf16x8*)(Ks + (jb * 16 + r) * 72 + ks * 32 + g * 8); accK = MFMA(bj, aK[ks], accK); accQ = MFMA(bj, aQ[ks], accQ); }
        f32x4 LvF, LvB; float ivF[4], ivB[4];
#pragma unroll
        for (int jj = 0; jj < 4; ++jj) {
          const int b2 = 16 * jb + 4 * g + jj, jbk = 63 - b2;
          const float eF = __expf(gF - gcs[b2]), eB = __expf(gB - gcs[64 + jbk]);
          LvF[jj] = (b2 < a) ? bF * accK[jj] * eF : 0.f; ivF[jj] = (b2 <= a) ? accQ[jj] * eF : 0.f;
          LvB[3 - jj] = (jbk < cb) ? bB * accK[jj] * eB : 0.f; ivB[3 - jj] = (jbk <= cb) ? accQ[jj] * eB : 0.f;
        }
        const int j0F = 16 * jb + 4 * g, j0B = 60 - 16 * jb - 4 * g;
        *(f32x4*)(LsF + a * 64 + j0F) = LvF;
        *(f32x4*)(LsB + cb * 64 + j0B) = LvB;
        *(s16x4*)(p.DNI + idxF * 4096 + a * 64 + j0F) = pack4(ivF[0], ivF[1], ivF[2], ivF[3]);
        *(s16x4*)(p.DNI + idxB * 4096 + cb * 64 + j0B) = pack4(ivB[0], ivB[1], ivB[2], ivB[3]);
      }
    }
    __syncthreads();
    if (it + NVB < 2176) DNC_ISSUE(it + NVB);
    asm volatile("" : "+v"(tid)); lane = tid & 63; w = tid >> 6;
    {
      const int sd = w >> 1, col = lane; const bool isK = (w & 1) != 0;
      const float* fac = (isK ? bexp : betas) + sd * 64; const float* Ls = sd ? LsB : LsF;
      const bf16_t* rp = (isK ? Ks : Vs) + (sd ? 63 * 72 : 0) + col; const int rst = sd ? -72 : 72;
      float X[64];
#pragma unroll
      for (int i = 0; i < 64; ++i) X[i] = 0.f;
#pragma unroll
      for (int i = 0; i < 64; ++i) {
        float a0 = bf2f(*rp) * fac[i], a1 = 0.f, a2 = 0.f, a3 = 0.f; rp += rst;
#pragma unroll
        for (int j4 = 0; j4 < (i + 3) / 4; ++j4) {
          const f32x4 lv = *(const f32x4*)(Ls + i * 64 + j4 * 4);
          a0 -= lv[0] * X[j4 * 4]; a1 -= lv[1] * X[j4 * 4 + 1]; a2 -= lv[2] * X[j4 * 4 + 2]; a3 -= lv[3] * X[j4 * 4 + 3];
        }
        X[i] = (a0 + a1) + (a2 + a3);
      }
      bf16_t* dst = (isK ? p.DNW : p.DNU) + (sd ? idxB : idxF) * 4096;
#pragma unroll
      for (int i = 0; i < 64; ++i) dst[i * 64 + col] = f2bf(X[i]);
    }
  }
#undef DNC_DECODE
#undef DNC_ISSUE
}

__device__ __forceinline__ void dn_scan(const Params& p, int item, unsigned char* lds) {
  bf16_t* Wt = (bf16_t*)lds; bf16_t* INs = Wt + 64 * 72; bf16_t* Qs = INs + 64 * 72; bf16_t* KT = Qs + 64 * 72;
  bf16_t* Us = KT + 64 * 72; bf16_t* sT = Us + 64 * 24; bf16_t* vT = sT + 16 * 72; bf16_t* v2T = vT + 16 * 72; float* gcs = (float*)(v2T + 16 * 72);
  const int tid = opaque_tid(), lane = tid & 63, w = tid >> 6, r = lane & 15, g = lane >> 4;
  const int slice = item & 3, seqid = item >> 2, dir = seqid & 1, h = (seqid >> 1) & 3, b = seqid >> 3;
  bf16_t* Od = dir ? p.OB : p.OF;
  f32x4 sreg = {0.f, 0.f, 0.f, 0.f};
  u32x4 rW[2], rI[2], rQ[2], rK[2], rU = {0u, 0u, 0u, 0u}; float rg = 0.f;
  int tokbase_cur = 0, tokbase_nxt = 0;
#define DN_ISSUE(stp) do { const int _st = (stp); const size_t _idx = (size_t)seqid * 68 + _st; \
    tokbase_nxt = (_st < 4) ? NLAT + b * 256 + (dir ? 3 - _st : _st) * 64 : b * 4096 + (dir ? 63 - (_st - 4) : (_st - 4)) * 64; \
    _Pragma("unroll") for (int i = 0; i < 2; ++i) { const int id = tid + 256 * i; \
      rW[i] = ((const u32x4*)(p.DNW + _idx * 4096))[id]; rI[i] = ((const u32x4*)(p.DNI + _idx * 4096))[id]; \
      { const int row = id >> 3, kc = id & 7; rQ[i] = *(const u32x4*)(p.QKVd + (size_t)(tokbase_nxt + (dir ? 63 - row : row)) * 768 + h * 64 + kc * 8); } \
      { const int cc = id & 63, kc2 = id >> 6; rK[i] = *(const u32x4*)(p.QKVd + (size_t)(tokbase_nxt + (dir ? 63 - cc : cc)) * 768 + 256 + h * 64 + kc2 * 8); } } \
    if (tid < 128) rU = *(const u32x4*)(p.DNU + _idx * 4096 + (tid >> 1) * 64 + slice * 16 + (tid & 1) * 8); \
    if (tid < 64) rg = p.DGC[_idx * 64 + tid]; } while (0)
  DN_ISSUE(0);
  for (int step = 0; step < 68; ++step) {
    __syncthreads();
    tokbase_cur = tokbase_nxt;
#pragma unroll
    for (int i = 0; i < 2; ++i) {
      const int id = tid + 256 * i, row = id >> 3, kc = id & 7;
      *(u32x4*)(Wt + row * 72 + kc * 8) = rW[i]; *(u32x4*)(INs + row * 72 + kc * 8) = rI[i]; *(u32x4*)(Qs + row * 72 + kc * 8) = rQ[i];
      const int cc = id & 63, kc2 = id >> 6; const u32x4 kv = rK[i];
#pragma unroll
      for (int e = 0; e < 4; ++e) { KT[(kc2 * 8 + 2 * e) * 72 + cc] = (bf16_t)(kv[e] & 0xffffu); KT[(kc2 * 8 + 2 * e + 1) * 72 + cc] = (bf16_t)(kv[e] >> 16); }
    }
    if (tid < 128) *(u32x4*)(Us + (tid >> 1) * 24 + (tid & 1) * 8) = rU;
    if (tid < 64) gcs[tid] = rg;
    *(s16x4*)(sT + r * 72 + 16 * w + 4 * g) = pack4(sreg[0], sreg[1], sreg[2], sreg[3]);
    __syncthreads();
    if (step + 1 < 68) DN_ISSUE(step + 1);
    const float glast = gcs[63];
    {
      f32x4 acc = {0.f, 0.f, 0.f, 0.f};
#pragma unroll
      for (int ks = 0; ks < 2; ++ks) acc = MFMA(*(const bf16x8*)(Wt + (16 * w + r) * 72 + ks * 32 + g * 8), *(const bf16x8*)(sT + r * 72 + ks * 32 + g * 8), acc);
      float vn[4], v2[4];
#pragma unroll
      for (int jj = 0; jj < 4; ++jj) { const int c = 16 * w + 4 * g + jj; vn[jj] = bf2f(Us[c * 24 + r]) - acc[jj]; v2[jj] = vn[jj] * __expf(glast - gcs[c]); }
      *(s16x4*)(vT + r * 72 + 16 * w + 4 * g) = pack4(vn[0], vn[1], vn[2], vn[3]);
      *(s16x4*)(v2T + r * 72 + 16 * w + 4 * g) = pack4(v2[0], v2[1], v2[2], v2[3]);
    }
    __syncthreads();
    {
      f32x4 a1 = {0.f, 0.f, 0.f, 0.f}, a2 = {0.f, 0.f, 0.f, 0.f}, a3 = {0.f, 0.f, 0.f, 0.f};
#pragma unroll
      for (int ks = 0; ks < 2; ++ks) {
        const bf16x8 sb = *(const bf16x8*)(sT + r * 72 + ks * 32 + g * 8);
        a1 = MFMA(*(const bf16x8*)(Qs + (16 * w + r) * 72 + ks * 32 + g * 8), sb, a1);
        a2 = MFMA(*(const bf16x8*)(INs + (16 * w + r) * 72 + ks * 32 + g * 8), *(const bf16x8*)(vT + r * 72 + ks * 32 + g * 8), a2);
        a3 = MFMA(*(const bf16x8*)(KT + (16 * w + r) * 72 + ks * 32 + g * 8), *(const bf16x8*)(v2T + r * 72 + ks * 32 + g * 8), a3);
      }
#pragma unroll
      for (int jj = 0; jj < 4; ++jj) { const int c = 16 * w + 4 * g + jj; const float o = __expf(gcs[c]) * a1[jj] + a2[jj];
        Od[(size_t)(tokbase_cur + (dir ? 63 - c : c)) * 256 + h * 64 + slice * 16 + r] = f2bf(o); }
      const float eg = __expf(glast);
      sreg = sreg * eg + a3;
    }
  }
#undef DN_ISSUE
}

__device__ __forceinline__ void gated_out(const Params& p, int layer, int M) {
  const int tid = opaque_tid(); const int lane = tid & 63, w = tid >> 6;
  const float ng = p.dn_norm_g[layer * 64 + lane];
  for (int tok0 = (VB * 4 + w) * 4; tok0 < M; tok0 += NVB * 16) {
    bf16_t a[4][4], bq[4][4], zz[4][4];
#pragma unroll
    for (int k = 0; k < 4; ++k)
#pragma unroll
      for (int h = 0; h < 4; ++h) { const size_t tok = tok0 + k;
        a[k][h] = p.OF[tok * 256 + h * 64 + lane]; bq[k][h] = p.OB[tok * 256 + h * 64 + lane]; zz[k][h] = p.U[tok * UW + 512 + h * 64 + lane]; }
#pragma unroll
    for (int k = 0; k < 4; ++k)
#pragma unroll
      for (int h = 0; h < 4; ++h) {
        const float o = bf2f(a[k][h]) + bf2f(bq[k][h]);
        const float ss = wave_sum(o * o);
        const float z = bf2f(zz[k][h]);
        p.XN[(size_t)(tok0 + k) * DM + 256 + h * 64 + lane] = f2bf(o * rsqrtf(ss * (1.f / 64.f) + EPSF) * ng * (z * __builtin_amdgcn_rcpf(1.f + __expf(-z))));
      }
  }
}

template <int DQK, int QB, int MODE>
__device__ __forceinline__ void attn_item(const Params& p, int layer, bool ctxq, int b, int h, int qt, unsigned char* lds) {
  constexpr int LDQ = DQK + 8, NQ = 64 * QB, NKS = DQK / 32, NP = DQK / 2;
  bf16_t* Qs = (bf16_t*)lds; bf16_t* Ks = Qs + NQ * LDQ; bf16_t* Vt = Ks + 64 * LDQ; float* rpbs = (float*)(Vt + 64 * 72);
  const int tid = opaque_tid(), lane = tid & 63, w = tid >> 6, r = lane & 15, g = lane >> 4;
  const int qtok0 = ctxq ? NLAT + b * 256 + qt * NQ : b * 4096 + qt * NQ;
  const int spos0 = qt * NQ;
#define QROW(qb) (MODE == 1 ? (qb) * 64 + w * 16 : (w * QB + (qb)) * 16)
  __syncthreads();
  {
    const bf16_t* qsrc; int qld; float scale;
    if (MODE == 0) { qsrc = p.U + h * 64; qld = UW; scale = 0.125f * 1.4426950408889634f; }
    else if (MODE == 1) { qsrc = p.U + 1200 + h * 64; qld = UW; scale = 0.125f * 1.4426950408889634f; }
    else { qsrc = p.QM + h * 96; qld = 384; scale = 0.10206207261596577f * 1.4426950408889634f; }
    {
      constexpr int CPR = DQK / 8;
#pragma unroll
      for (int i = 0; i < (NQ * CPR) / 256; ++i) { const int id = tid + 256 * i, q = id / CPR, c = id - q * CPR;
        *(u32x4*)(Qs + q * LDQ + c * 8) = *(const u32x4*)(qsrc + (size_t)(qtok0 + q) * qld + c * 8); }
    }
    __syncthreads();
    for (int e = tid; e < NQ * NP; e += 256) {
      const int q = e / NP, pi = e - q * NP;
      int d1, d2; float inv = 0.f; int usecol = 0; bool rot = false;
      if (MODE == 0) { const int half = pi >> 4, i = pi & 15; d1 = half * 32 + i; d2 = d1 + 16; rot = !ctxq; usecol = half; inv = exp2f(-(float)i * (13.287712379549449f / 16.f)); }
      else if (MODE == 2 && pi >= 32) { const int pp = pi - 32, half = pp >> 3, i = pp & 7; d1 = 64 + half * 16 + i; d2 = d1 + 8; rot = !ctxq; usecol = half; inv = exp2f(-(float)i * (13.287712379549449f / 8.f)); }
      else { d1 = 2 * pi; d2 = d1 + 1; }
      const float t1 = bf2f(Qs[q * LDQ + d1]), t2 = bf2f(Qs[q * LDQ + d2]);
      float o1 = t1, o2 = t2;
      if (rot) { const int sp = spos0 + q; const float pos = usecol ? (float)(sp & 63) : (float)(sp >> 6); float sn, cs; fast_sincos(pos * inv, sn, cs); o1 = t1 * cs - t2 * sn; o2 = t2 * cs + t1 * sn; }
      Qs[q * LDQ + d1] = f2bf(o1 * scale); Qs[q * LDQ + d2] = f2bf(o2 * scale);
    }
    if (MODE == 1) for (int e = tid; e < 465; e += 256) rpbs[e] = p.na_rpb[(size_t)(layer * 4 + h) * 465 + e] * 1.4426950408889634f;
  }
  __syncthreads();
  bf16x8 qf[QB][NKS];
#pragma unroll
  for (int qb = 0; qb < QB; ++qb)
#pragma unroll
    for (int ks = 0; ks < NKS; ++ks) qf[qb][ks] = *(const bf16x8*)(Qs + (QROW(qb) + r) * LDQ + ks * 32 + g * 8);
  f32x4 o[QB][4]; float mrun[QB], lrun[QB];
#pragma unroll
  for (int qb = 0; qb < QB; ++qb) { mrun[qb] = -1e30f; lrun[qb] = 0.f;
#pragma unroll
    for (int db = 0; db < 4; ++db) o[qb][db] = (f32x4){0.f, 0.f, 0.f, 0.f}; }
  int nloc = 0, loc0 = 0;
  if (!ctxq) {
    if (MODE == 0) { loc0 = 2 * qt - 2; nloc = 6; }
    else if (MODE == 1) { loc0 = 2 * qt - 4 < 0 ? 0 : (2 * qt - 4 > 56 ? 56 : 2 * qt - 4); nloc = 9; }
    else { loc0 = 0; nloc = 64; }
  }
  const int ntiles = nloc + 4;
  const int kb_lo = (MODE == 1) ? (w == 0 ? 0 : (w == 1 ? 0 : (w == 2 ? 1 : 2))) : 0, kb_hi = (MODE == 1) ? (w == 0 ? 1 : (w == 1 ? 2 : 3)) : 3;
  const int voff = MODE == 0 ? 384 + (h >> 1) * 64 : 1712 + h * 64;
  const int koff = MODE == 0 ? 256 + (h >> 1) * 64 : 1456 + h * 64;
  constexpr int NKC = (DQK * 8) / 256;
  u32x4 rk[NKC], rv[2];
#define ATT_ISSUE(TI) do { const int _ti = (TI); const bool _loc = _ti < nloc; const int _jt = _loc ? loc0 + _ti : _ti - nloc; \
    const int _jtc = _jt < 0 ? 0 : (_jt > 63 ? 63 : _jt); const int _k0 = _loc ? b * 4096 + _jtc * 64 : NLAT + b * 256 + _jt * 64; \
    _Pragma("unroll") for (int i = 0; i < NKC; ++i) { const int id = tid + 256 * i; \
      if (MODE == 2) { const int row = id / 12, kc = id - row * 12; \
        rk[i] = *(const u32x4*)(kc < 8 ? p.KVM + (size_t)(_k0 + row) * 512 + h * 128 + kc * 8 : p.U + (size_t)(_k0 + row) * UW + 1168 + (kc - 8) * 8); } \
      else { const int row = id >> 3, kc = id & 7; rk[i] = *(const u32x4*)(p.U + (size_t)(_k0 + row) * UW + koff + kc * 8); } } \
    _Pragma("unroll") for (int i = 0; i < 2; ++i) { const int key = 2 * (tid & 31) + i, dc = tid >> 5; \
      rv[i] = *(const u32x4*)(MODE == 2 ? p.KVM + (size_t)(_k0 + key) * 512 + h * 128 + 64 + dc * 8 : p.U + (size_t)(_k0 + key) * UW + voff + dc * 8); } } while (0)
  ATT_ISSUE(0);
  for (int ti = 0; ti < ntiles; ++ti) {
    const bool isloc = ti < nloc;
    const int jt = isloc ? loc0 + ti : ti - nloc;
    const bool oob = jt < 0 || jt > 63;
    __syncthreads();
#pragma unroll
    for (int i = 0; i < NKC; ++i) { const int id = tid + 256 * i;
      if (MODE == 2) { const int row = id / 12, kc = id - row * 12; *(u32x4*)(Ks + row * LDQ + kc * 8) = rk[i]; }
      else { const int row = id >> 3, kc = id & 7; *(u32x4*)(Ks + row * LDQ + kc * 8) = rk[i]; } }
    {
      const int kp = tid & 31, dc = tid >> 5; const u32x4 va = rv[0], vb = rv[1];
#pragma unroll
      for (int e = 0; e < 4; ++e) {
        *(unsigned*)(Vt + (dc * 8 + 2 * e) * 72 + 2 * kp) = (va[e] & 0xffffu) | (vb[e] << 16);
        *(unsigned*)(Vt + (dc * 8 + 2 * e + 1) * 72 + 2 * kp) = (va[e] >> 16) | (vb[e] & 0xffff0000u);
      }
    }
    __syncthreads();
    if (ti + 1 < ntiles) ATT_ISSUE(ti + 1);
    f32x4 s[QB][4];
#pragma unroll
    for (int qb = 0; qb < QB; ++qb)
#pragma unroll
      for (int kb = 0; kb < 4; ++kb) s[qb][kb] = (f32x4){0.f, 0.f, 0.f, 0.f};
    const bool narrow = (MODE == 1) && isloc;
#pragma unroll
    for (int kb = 0; kb < 4; ++kb) {
      if (narrow && (kb < kb_lo || kb > kb_hi)) continue;
#pragma unroll
      for (int ks = 0; ks < NKS; ++ks) {
        const bf16x8 a = *(const bf16x8*)(Ks + (kb * 16 + r) * LDQ + ks * 32 + g * 8);
#pragma unroll
        for (int qb = 0; qb < QB; ++qb) s[qb][kb] = MFMA(a, qf[qb][ks], s[qb][kb]);
      }
    }
    bf16x8 pf[QB][2];
#pragma unroll
    for (int qb = 0; qb < QB; ++qb) {
      const int qi = QROW(qb) + r;
      float mx = -1e30f;
#pragma unroll
      for (int kb = 0; kb < 4; ++kb)
#pragma unroll
        for (int jj = 0; jj < 4; ++jj) {
          float sv = s[qb][kb][jj];
          if (isloc && MODE == 0) { const int key = kb * 16 + 4 * g + jj; const int dlt = (qt * NQ + qi) - (jt * 64 + key); if (oob || dlt > 128 || dlt < -128) sv = -1e30f; }
          if (isloc && MODE == 1) { const int key = kb * 16 + 4 * g + jj; const int qc = qi & 63, rq = 2 * qt + (qi >> 6);
            int cs0 = qc - 8; cs0 = cs0 < 0 ? 0 : (cs0 > 48 ? 48 : cs0); int rs0 = rq - 4; rs0 = rs0 < 0 ? 0 : (rs0 > 56 ? 56 : rs0);
            if (!oob && kb >= kb_lo && kb <= kb_hi && jt >= rs0 && jt < rs0 + 8 && key >= cs0 && key < cs0 + 16) sv += rpbs[(jt - rq + 7) * 31 + (key - qc + 15)]; else sv = -1e30f; }
          s[qb][kb][jj] = sv; mx = fmaxf(mx, sv);
        }
      mx = fmaxf(mx, __shfl_xor(mx, 16)); mx = fmaxf(mx, __shfl_xor(mx, 32));
      const float mnew = fmaxf(mrun[qb], mx);
      const float alpha = __builtin_amdgcn_exp2f(mrun[qb] - mnew);
      mrun[qb] = mnew;
      float ps = 0.f; float pv[4][4];
#pragma unroll
      for (int kb = 0; kb < 4; ++kb)
#pragma unroll
        for (int jj = 0; jj < 4; ++jj) { const float sv = s[qb][kb][jj]; const float pe = (MODE == 2 || sv > -1e29f) ? __builtin_amdgcn_exp2f(sv - mnew) : 0.f; pv[kb][jj] = pe; ps += pe; }
      lrun[qb] = lrun[qb] * alpha + ps;
#pragma unroll
      for (int db = 0; db < 4; ++db) o[qb][db] = o[qb][db] * alpha;
#pragma unroll
      for (int k2 = 0; k2 < 2; ++k2) {
        const s16x4 lo = pack4(pv[2 * k2][0], pv[2 * k2][1], pv[2 * k2][2], pv[2 * k2][3]);
        const s16x4 hi = pack4(pv[2 * k2 + 1][0], pv[2 * k2 + 1][1], pv[2 * k2 + 1][2], pv[2 * k2 + 1][3]);
        pf[qb][k2] = __builtin_shufflevector(lo, hi, 0, 1, 2, 3, 4, 5, 6, 7);
      }
    }
#pragma unroll
    for (int k2 = 0; k2 < 2; ++k2) {
      if (narrow && ((k2 == 0 && kb_lo > 1) || (k2 == 1 && kb_hi < 2))) continue;
#pragma unroll
      for (int db = 0; db < 4; ++db) {
        const s16x4 lo = *(const s16x4*)(Vt + (db * 16 + r) * 72 + k2 * 32 + 4 * g);
        const s16x4 hi = *(const s16x4*)(Vt + (db * 16 + r) * 72 + k2 * 32 + 16 + 4 * g);
        const bf16x8 a = __builtin_shufflevector(lo, hi, 0, 1, 2, 3, 4, 5, 6, 7);
#pragma unroll
        for (int qb = 0; qb < QB; ++qb) o[qb][db] = MFMA(a, pf[qb][k2], o[qb][db]);
      }
    }
  }
  const int ycol = (MODE == 0 ? 0 : (MODE == 1 ? 768 : 512)) + h * 64;
#pragma unroll
  for (int qb = 0; qb < QB; ++qb) {
    float lt = lrun[qb]; lt += __shfl_xor(lt, 16); lt += __shfl_xor(lt, 32);
    if (MODE == 0) lt += __builtin_amdgcn_exp2f(p.swa_sink[layer * 4 + h] * 1.4426950408889634f - mrun[qb]);
    const float inv = 1.f / lt;
    const size_t qtok = (size_t)qtok0 + QROW(qb) + r;
#pragma unroll
    for (int db = 0; db < 4; ++db) *(s16x4*)(p.XN + qtok * DM + ycol + db * 16 + 4 * g) = pack4(o[qb][db][0] * inv, o[qb][db][1] * inv, o[qb][db][2] * inv, o[qb][db][3] * inv);
  }
}
#undef QROW

template <bool FAST>
__device__ __forceinline__ void mla_loop(const Params& p, int b, int h, int tid, int r, int g, bf16_t* Kb0, bf16_t* Kb1, bf16_t* Vt,
                                         const bf16x8 (&qf)[2][3], f32x4 (&o)[2][4], f32x4 (&o5)[2], float (&mrun)[2], float (&lrun)[2]) {
  constexpr int LDQ = 104;
  u32x4 rk[3], rv[2];
#define MLA_TOK0(TI) ((TI) < 4 ? NLAT + b * 256 + (TI) * 64 : b * 4096 + ((TI) - 4) * 64)
#define MLA_LOADK(TI) do { const int _k0 = MLA_TOK0(TI); _Pragma("unroll") for (int i = 0; i < 3; ++i) { const int id = tid + 256 * i, row = id / 12, kc = id - row * 12; \
      rk[i] = *(const u32x4*)(kc < 8 ? p.KVM + (size_t)(_k0 + row) * 512 + h * 128 + kc * 8 : p.U + (size_t)(_k0 + row) * UW + 1168 + (kc - 8) * 8); } } while (0)
#define MLA_LOADV(TI) do { const int _k0 = MLA_TOK0(TI); _Pragma("unroll") for (int i = 0; i < 2; ++i) { const int key = 2 * (tid & 31) + i, dc = tid >> 5; \
      rv[i] = *(const u32x4*)(p.KVM + (size_t)(_k0 + key) * 512 + h * 128 + 64 + dc * 8); } } while (0)
#define MLA_STOREK(KB) do { _Pragma("unroll") for (int i = 0; i < 3; ++i) { const int id = tid + 256 * i, row = id / 12, kc = id - row * 12; *(u32x4*)((KB) + row * LDQ + kc * 8) = rk[i]; } } while (0)
  MLA_LOADK(0); MLA_LOADV(0);
  MLA_STOREK(Kb0);
  MLA_LOADK(1);
  __syncthreads();
  f32x4 sc[2][4];
#pragma unroll
  for (int qb = 0; qb < 2; ++qb)
#pragma unroll
    for (int kb = 0; kb < 4; ++kb) sc[qb][kb] = (f32x4){0.f, 0.f, 0.f, 0.f};
#pragma unroll
  for (int kb = 0; kb < 4; ++kb)
#pragma unroll
    for (int ks = 0; ks < 3; ++ks) { const bf16x8 a = *(const bf16x8*)(Kb0 + (kb * 16 + r) * LDQ + ks * 32 + g * 8);
#pragma unroll
      for (int qb = 0; qb < 2; ++qb) sc[qb][kb] = MFMA(a, qf[qb][ks], sc[qb][kb]); }
  for (int ti = 0; ti < 68; ++ti) {
    const bool has_next = ti + 1 < 68;
    const bf16_t* Kn = ((ti + 1) & 1) ? Kb1 : Kb0;
    __syncthreads();
    {
      const int kp = tid & 31, dc = tid >> 5; const u32x4 va = rv[0], vb = rv[1];
#pragma unroll
      for (int e = 0; e < 4; ++e) {
        *(unsigned*)(Vt + (dc * 8 + 2 * e) * 72 + 2 * kp) = (va[e] & 0xffffu) | (vb[e] << 16);
        *(unsigned*)(Vt + (dc * 8 + 2 * e + 1) * 72 + 2 * kp) = (va[e] >> 16) | (vb[e] & 0xffff0000u);
      }
    }
    if (has_next) MLA_STOREK((bf16_t*)Kn);
    __syncthreads();
    if (ti + 2 < 68) MLA_LOADK(ti + 2);
    if (has_next) MLA_LOADV(ti + 1);
    float mnew[2] = {0.f, 0.f};
    if (!FAST) {
#pragma unroll
      for (int qb = 0; qb < 2; ++qb) {
        float mk[4];
#pragma unroll
        for (int kb = 0; kb < 4; ++kb) mk[kb] = fmaxf(fmaxf(sc[qb][kb][0], sc[qb][kb][1]), fmaxf(sc[qb][kb][2], sc[qb][kb][3]));
        float mx = fmaxf(fmaxf(mk[0], mk[1]), fmaxf(mk[2], mk[3]));
        mx = fmaxf(mx, __shfl_xor(mx, 16)); mx = fmaxf(mx, __shfl_xor(mx, 32));
        mnew[qb] = fmaxf(mrun[qb], mx);
        const float alpha = __builtin_amdgcn_exp2f(mrun[qb] - mnew[qb]);
        mrun[qb] = mnew[qb]; lrun[qb] *= alpha;
#pragma unroll
        for (int db = 0; db < 4; ++db) o[qb][db] = o[qb][db] * alpha;
      }
    }
    f32x4 sn[2][4]; float pv[2][4][4];
#pragma unroll
    for (int qb = 0; qb < 2; ++qb)
#pragma unroll
      for (int kb = 0; kb < 4; ++kb) sn[qb][kb] = (f32x4){0.f, 0.f, 0.f, 0.f};
#pragma unroll
    for (int kb = 0; kb < 4; ++kb) {
      if (has_next) {
#pragma unroll
        for (int ks = 0; ks < 3; ++ks) { const bf16x8 a = *(const bf16x8*)(Kn + (kb * 16 + r) * LDQ + ks * 32 + g * 8);
#pragma unroll
          for (int qb = 0; qb < 2; ++qb) sn[qb][kb] = MFMA(a, qf[qb][ks], sn[qb][kb]); }
      }
#pragma unroll
      for (int qb = 0; qb < 2; ++qb) {
#pragma unroll
        for (int jj = 0; jj < 4; ++jj) pv[qb][kb][jj] = FAST ? __builtin_amdgcn_exp2f(sc[qb][kb][jj]) : __builtin_amdgcn_exp2f(sc[qb][kb][jj] - mnew[qb]);
        if (!FAST) lrun[qb] += (pv[qb][kb][0] + pv[qb][kb][1]) + (pv[qb][kb][2] + pv[qb][kb][3]);
      }
    }
#pragma unroll
    for (int k2 = 0; k2 < 2; ++k2) {
      bf16x8 pf[2];
#pragma unroll
      for (int qb = 0; qb < 2; ++qb) {
        const s16x4 lo = pack4(pv[qb][2 * k2][0], pv[qb][2 * k2][1], pv[qb][2 * k2][2], pv[qb][2 * k2][3]);
        const s16x4 hi = pack4(pv[qb][2 * k2 + 1][0], pv[qb][2 * k2 + 1][1], pv[qb][2 * k2 + 1][2], pv[qb][2 * k2 + 1][3]);
        pf[qb] = __builtin_shufflevector(lo, hi, 0, 1, 2, 3, 4, 5, 6, 7);
      }
#pragma unroll
      for (int db = 0; db < (FAST ? 5 : 4); ++db) {
        const s16x4 lo = *(const s16x4*)(Vt + (db * 16 + r) * 72 + k2 * 32 + 4 * g);
        const s16x4 hi = *(const s16x4*)(Vt + (db * 16 + r) * 72 + k2 * 32 + 16 + 4 * g);
        const bf16x8 a = __builtin_shufflevector(lo, hi, 0, 1, 2, 3, 4, 5, 6, 7);
#pragma unroll
        for (int qb = 0; qb < 2; ++qb) { if (db < 4) o[qb][db < 4 ? db : 0] = MFMA(a, pf[qb], o[qb][db < 4 ? db : 0]); else o5[qb] = MFMA(a, pf[qb], o5[qb]); }
      }
    }
#pragma unroll
    for (int qb = 0; qb < 2; ++qb)
#pragma unroll
      for (int kb = 0; kb < 4; ++kb) sc[qb][kb] = sn[qb][kb];
  }
#undef MLA_TOK0
#undef MLA_LOADK
#undef MLA_LOADV
#undef MLA_STOREK
}

__device__ __forceinline__ void mla_fast128(const Params& p, int b, int h, int tid, int r, int g, bf16_t* Kt, bf16_t* Vt,
                                            const bf16x8 (&qf)[2][3], f32x4 (&o)[2][4], f32x4 (&o5)[2]) {
  constexpr int LDQ = 104, LDV = 136;
  u32x4 rk[6], rv[4];
#define M128_TOK0(TI) ((TI) < 2 ? NLAT + b * 256 + (TI) * 128 : b * 4096 + ((TI) - 2) * 128)
#define M128_LOAD(TI) do { const int _k0 = M128_TOK0(TI); \
    _Pragma("unroll") for (int i = 0; i < 6; ++i) { const int id = tid + 256 * i, row = id / 12, kc = id - row * 12; \
      rk[i] = *(const u32x4*)(kc < 8 ? p.KVM + (size_t)(_k0 + row) * 512 + h * 128 + kc * 8 : p.U + (size_t)(_k0 + row) * UW + 1168 + (kc - 8) * 8); } \
    _Pragma("unroll") for (int i = 0; i < 4; ++i) { const int key = 2 * (tid & 63) + (i & 1), dc = (tid >> 6) + 4 * (i >> 1); \
      rv[i] = *(const u32x4*)(p.KVM + (size_t)(_k0 + key) * 512 + h * 128 + 64 + dc * 8); } } while (0)
  M128_LOAD(0);
  for (int ti = 0; ti < 34; ++ti) {
    __syncthreads();
    if (ti == 0) for (int e = tid; e < 16 * LDV; e += 256) Vt[64 * LDV + e] = (e < LDV) ? (bf16_t)0x3F80 : (bf16_t)0;
#pragma unroll
    for (int i = 0; i < 6; ++i) { const int id = tid + 256 * i, row = id / 12, kc = id - row * 12; *(u32x4*)(Kt + row * LDQ + kc * 8) = rk[i]; }
#pragma unroll
    for (int i2 = 0; i2 < 2; ++i2) {
      const int kp = tid & 63, dc = (tid >> 6) + 4 * i2; const u32x4 va = rv[2 * i2], vb = rv[2 * i2 + 1];
#pragma unroll
      for (int e = 0; e < 4; ++e) {
        *(unsigned*)(Vt + (dc * 8 + 2 * e) * LDV + 2 * kp) = (va[e] & 0xffffu) | (vb[e] << 16);
        *(unsigned*)(Vt + (dc * 8 + 2 * e + 1) * LDV + 2 * kp) = (va[e] >> 16) | (vb[e] & 0xffff0000u);
      }
    }
    __syncthreads();
    if (ti + 1 < 34) M128_LOAD(ti + 1);
#pragma unroll
    for (int k2 = 0; k2 < 4; ++k2) {
      f32x4 sc[2][2];
#pragma unroll
      for (int qb = 0; qb < 2; ++qb) { sc[qb][0] = (f32x4){0.f, 0.f, 0.f, 0.f}; sc[qb][1] = (f32x4){0.f, 0.f, 0.f, 0.f}; }
#pragma unroll
      for (int kk = 0; kk < 2; ++kk)
#pragma unroll
        for (int ks = 0; ks < 3; ++ks) { const bf16x8 a = *(const bf16x8*)(Kt + ((2 * k2 + kk) * 16 + r) * LDQ + ks * 32 + g * 8);
#pragma unroll
          for (int qb = 0; qb < 2; ++qb) sc[qb][kk] = MFMA(a, qf[qb][ks], sc[qb][kk]); }
      bf16x8 pf[2];
#pragma unroll
      for (int qb = 0; qb < 2; ++qb) {
        const s16x4 lo = pack4(__builtin_amdgcn_exp2f(sc[qb][0][0]), __builtin_amdgcn_exp2f(sc[qb][0][1]), __builtin_amdgcn_exp2f(sc[qb][0][2]), __builtin_amdgcn_exp2f(sc[qb][0][3]));
        const s16x4 hi = pack4(__builtin_amdgcn_exp2f(sc[qb][1][0]), __builtin_amdgcn_exp2f(sc[qb][1][1]), __builtin_amdgcn_exp2f(sc[qb][1][2]), __builtin_amdgcn_exp2f(sc[qb][1][3]));
        pf[qb] = __builtin_shufflevector(lo, hi, 0, 1, 2, 3, 4, 5, 6, 7);
      }
#pragma unroll
      for (int db = 0; db < 5; ++db) {
        const s16x4 lo = *(const s16x4*)(Vt + (db * 16 + r) * LDV + k2 * 32 + 4 * g);
        const s16x4 hi = *(const s16x4*)(Vt + (db * 16 + r) * LDV + k2 * 32 + 16 + 4 * g);
        const bf16x8 a = __builtin_shufflevector(lo, hi, 0, 1, 2, 3, 4, 5, 6, 7);
#pragma unroll
        for (int qb = 0; qb < 2; ++qb) { if (db < 4) o[qb][db < 4 ? db : 0] = MFMA(a, pf[qb], o[qb][db < 4 ? db : 0]); else o5[qb] = MFMA(a, pf[qb], o5[qb]); }
      }
    }
  }
#undef M128_TOK0
#undef M128_LOAD
}

__device__ __forceinline__ void mla_item(const Params& p, int layer, int b, int h, int qt, unsigned char* lds) {
  constexpr int LDQ = 104;
  bf16_t* Qs = (bf16_t*)lds; bf16_t* Kb0 = Qs + 128 * LDQ; bf16_t* Kb1 = Kb0 + 64 * LDQ; bf16_t* Vt = Kb1 + 64 * LDQ;
  float* qn = (float*)(Vt + 80 * 72);
  const int tid = opaque_tid(), lane = tid & 63, w = tid >> 6, r = lane & 15, g = lane >> 4;
  const int qtok0 = b * 4096 + qt * 128, spos0 = qt * 128;
  const unsigned kn_bits = __hip_atomic_load(p.kmx + layer * 32 + b * 4 + h, __ATOMIC_RELAXED, __HIP_MEMORY_SCOPE_AGENT), kr_bits = __hip_atomic_load(p.kmx + 64 + layer, __ATOMIC_RELAXED, __HIP_MEMORY_SCOPE_AGENT);
  __syncthreads();
  {
    const bf16_t* qsrc = p.QM + h * 96;
#pragma unroll
    for (int i = 0; i < 6; ++i) { const int id = tid + 256 * i, q = id / 12, c = id - q * 12;
      *(u32x4*)(Qs + q * LDQ + c * 8) = *(const u32x4*)(qsrc + (size_t)(qtok0 + q) * 384 + c * 8); }
    for (int e = tid; e < 16 * 72; e += 256) Vt[64 * 72 + e] = (e < 72) ? (bf16_t)0x3F80 : (bf16_t)0;
    __syncthreads();
    const float scale = 0.10206207261596577f * 1.4426950408889634f;
    for (int e = tid; e < 128 * 48; e += 256) {
      const int q = e / 48, pi = e - q * 48;
      int d1, d2; float inv = 0.f; int usecol = 0; bool rot = false;
      if (pi >= 32) { const int pp = pi - 32, hf = pp >> 3, i = pp & 7; d1 = 64 + hf * 16 + i; d2 = d1 + 8; rot = true; usecol = hf; inv = exp2f(-(float)i * (13.287712379549449f / 8.f)); }
      else { d1 = 2 * pi; d2 = d1 + 1; }
      const float t1 = bf2f(Qs[q * LDQ + d1]), t2 = bf2f(Qs[q * LDQ + d2]);
      float o1 = t1, o2 = t2;
      if (rot) { const int sp = spos0 + q; const float pos = usecol ? (float)(sp & 63) : (float)(sp >> 6); float sn, cs; fast_sincos(pos * inv, sn, cs); o1 = t1 * cs - t2 * sn; o2 = t2 * cs + t1 * sn; }
      Qs[q * LDQ + d1] = f2bf(o1 * scale); Qs[q * LDQ + d2] = f2bf(o2 * scale);
    }
    __syncthreads();
    if (tid < 128) { float ss = 0.f;
#pragma unroll
      for (int c = 0; c < 12; ++c) { const u32x4 v = *(const u32x4*)(Qs + tid * LDQ + c * 8);
#pragma unroll
        for (int e = 0; e < 4; ++e) { const float a = __uint_as_float(v[e] << 16), bb = __uint_as_float(v[e] & 0xffff0000u); ss += a * a + bb * bb; } }
      qn[tid] = ss; }
  }
  __syncthreads();
  bf16x8 qf[2][3];
#pragma unroll
  for (int qb = 0; qb < 2; ++qb)
#pragma unroll
    for (int ks = 0; ks < 3; ++ks) qf[qb][ks] = *(const bf16x8*)(Qs + ((w * 2 + qb) * 16 + r) * LDQ + ks * 32 + g * 8);
  float qmax2 = fmaxf(qn[lane], qn[lane + 64]);
#pragma unroll
  for (int of = 32; of >= 1; of >>= 1) qmax2 = fmaxf(qmax2, __shfl_xor(qmax2, of));
  const float kmax2 = __uint_as_float(kn_bits) + __uint_as_float(kr_bits);
  const float bound = sqrtf(qmax2 * kmax2);
  const bool fast = bound < 100.f;
  f32x4 o[2][4], o5[2]; float mrun[2], lrun[2];
#pragma unroll
  for (int qb = 0; qb < 2; ++qb) { mrun[qb] = -1e30f; lrun[qb] = 0.f; o5[qb] = (f32x4){0.f, 0.f, 0.f, 0.f};
#pragma unroll
    for (int db = 0; db < 4; ++db) o[qb][db] = (f32x4){0.f, 0.f, 0.f, 0.f}; }
  if (fast) mla_fast128(p, b, h, tid, r, g, Qs, Qs + 128 * LDQ, qf, o, o5);
  else mla_loop<false>(p, b, h, tid, r, g, Kb0, Kb1, Vt, qf, o, o5, mrun, lrun);
  const int ycol = 512 + h * 64;
#pragma unroll
  for (int qb = 0; qb < 2; ++qb) {
    float lt;
    if (fast) lt = __shfl(o5[qb][0], r);
    else { lt = lrun[qb]; lt += __shfl_xor(lt, 16); lt += __shfl_xor(lt, 32); }
    const float inv = 1.f / lt;
    const size_t qtok = (size_t)qtok0 + (w * 2 + qb) * 16 + r;
#pragma unroll
    for (int db = 0; db < 4; ++db) *(s16x4*)(p.XN + qtok * DM + ycol + db * 16 + 4 * g) = pack4(o[qb][db][0] * inv, o[qb][db][1] * inv, o[qb][db][2] * inv, o[qb][db][3] * inv);
  }
}

__device__ __forceinline__ void mixer_phase(const Params& p, int layer, bool need_ctx, unsigned char* lds, volatile int* sitem) {
  for (int it = VB; it < 256; it += NVB) dn_scan(p, it, lds);
  const int half = raw_tid() >> 8;
  const int nMc = need_ctx ? 64 : 0, nSc = need_ctx ? 64 : 0;
  const int e0 = 1024, e1 = e0 + nMc, e2 = e1 + 1024, e3 = e2 + 1024, e4 = e3 + nSc, e5 = e4 + nSc;
  {
    const int x0 = (int)xb_xcc_id() & 7;
    for (int dx = 0; dx < 8; ++dx) {
      const int x = (x0 + dx) & 7;
      for (;;) {
        __syncthreads();
        if (raw_tid() == 0) *sitem = (int)atomicAdd(p.cnt + 16 + layer * 8 + x, 1u);
        __syncthreads();
        const int pr = *sitem;
        if (pr >= 64) break;
        const int li = 2 * pr + half, bh = 4 * x + (li >> 5);
        mla_item(p, layer, bh >> 2, bh & 3, li & 31, lds);
      }
    }
  }
  for (;;) {
    __syncthreads();
    if (raw_tid() == 0) *sitem = (int)atomicAdd(p.cnt + layer, 1u);
    __syncthreads();
    const int it = e0 + 2 * (*sitem) + half;
    if (it >= e5) break;
    if (it < e1) { const int j = it - e0; attn_item<96, 2, 2>(p, layer, true, j >> 3, (j >> 1) & 3, j & 1, lds); }
    else if (it < e2) { const int j = it - e1; attn_item<64, 2, 0>(p, layer, false, j >> 7, (j >> 5) & 3, j & 31, lds); }
    else if (it < e3) { const int j = it - e2; attn_item<64, 2, 1>(p, layer, false, j >> 7, (j >> 5) & 3, j & 31, lds); }
    else if (it < e4) { const int j = it - e3; attn_item<64, 2, 0>(p, layer, true, j >> 3, (j >> 1) & 3, j & 1, lds); }
    else { const int j = it - e4; attn_item<64, 2, 1>(p, layer, true, j >> 3, (j >> 1) & 3, j & 1, lds); }
  }
}

extern __shared__ __attribute__((aligned(16))) unsigned char dyn_shm[];
namespace g256 {
constexpr int BM = 256, BK = 64, HALF = 128, NXCD = 8, WGM = 8, HT = HALF * BK;
__device__ __forceinline__ int lds_byte(int r, int c) { int st = (r >> 4) * 2 + (c >> 5), rr = r & 15, cc = c & 31, ob = rr * 64 + cc * 2; return st * 1024 + (ob ^ (((ob >> 9) & 1) << 5)); }
__device__ __forceinline__ void stage_rc(int b, int& R, int& C) { int st = b / 1024, sb = b % 1024, swz = sb ^ (((sb >> 9) & 1) << 5); R = (st >> 1) * 16 + swz / 64; C = (st & 1) * 32 + (swz % 64) / 2; }
}
__device__ __forceinline__ void gemm64_ctx(const bf16_t* __restrict__ A, int lda, const bf16_t* __restrict__ Bt, int ldb, int K,
                                           const float* srcC, float* dstC, const float* mod, int gi, float fac, unsigned char* lds) {
  constexpr int LDT = 136;
  bf16_t* As = (bf16_t*)lds; bf16_t* Bs = As + 64 * LDT;
  const int tid = opaque_tid(), lane = tid & 63, w = tid >> 6, wr = w >> 1, wc = w & 1, r = lane & 15, gq = lane >> 4;
  const int ntn = DM / 64, nt = (NCTX / 64) * ntn, nk = K / 128;
  for (int tile = VB; tile < nt; tile += NVB) {
    const int pm = tile / ntn, pn = tile - pm * ntn;
    const bf16_t* Ag = A + (size_t)(pm * 64) * lda; const bf16_t* Bg = Bt + (size_t)(pn * 64) * ldb;
    f32x4 acc[2][2];
#pragma unroll
    for (int m = 0; m < 2; ++m)
#pragma unroll
      for (int n = 0; n < 2; ++n) acc[m][n] = (f32x4){0.f, 0.f, 0.f, 0.f};
    u32x4 ra[2][4], rb[2][4];
#define G64_LOAD(S, KT) do { const int _k0 = (KT) * 128; _Pragma("unroll") for (int i = 0; i < 4; ++i) { const int id = tid + 256 * i, row = id >> 4, kc = id & 15; \
      ra[S][i] = *(const u32x4*)(Ag + (size_t)row * lda + _k0 + kc * 8); rb[S][i] = *(const u32x4*)(Bg + (size_t)row * ldb + _k0 + kc * 8); } } while (0)
#define G64_STEP(S, KT) do { __syncthreads(); \
      _Pragma("unroll") for (int i = 0; i < 4; ++i) { const int id = tid + 256 * i, row = id >> 4, kc = id & 15; \
        *(u32x4*)(As + row * LDT + kc * 8) = ra[S][i]; *(u32x4*)(Bs + row * LDT + kc * 8) = rb[S][i]; } \
      __syncthreads(); \
      if ((KT) + 2 < nk) G64_LOAD(S, (KT) + 2); \
      _Pragma("unroll") for (int ks = 0; ks < 4; ++ks) { bf16x8 af[2], bfr[2]; \
        _Pragma("unroll") for (int m = 0; m < 2; ++m) af[m] = *(const bf16x8*)(As + (wr * 32 + m * 16 + r) * LDT + ks * 32 + gq * 8); \
        _Pragma("unroll") for (int n = 0; n < 2; ++n) bfr[n] = *(const bf16x8*)(Bs + (wc * 32 + n * 16 + r) * LDT + ks * 32 + gq * 8); \
        _Pragma("unroll") for (int m = 0; m < 2; ++m) _Pragma("unroll") for (int n = 0; n < 2; ++n) acc[m][n] = MFMA(bfr[n], af[m], acc[m][n]); } } while (0)
    G64_LOAD(0, 0); G64_LOAD(1, 1);
    for (int kt = 0; kt < nk; kt += 2) { G64_STEP(0, kt); G64_STEP(1, kt + 1); }
#undef G64_LOAD
#undef G64_STEP
    const float* mp = mod + 8 * 9216 + gi * 1024;
#pragma unroll
    for (int m = 0; m < 2; ++m) {
      const int row = pm * 64 + wr * 32 + m * 16 + r;
#pragma unroll
      for (int n = 0; n < 2; ++n) {
        const int col = pn * 64 + wc * 32 + n * 16 + 4 * gq;
        const f32x4 gt = *(const f32x4*)(mp + col);
        const f32x4 sv = *(const f32x4*)(srcC + (size_t)row * DM + col);
        *(f32x4*)(dstC + (size_t)row * DM + col) = sv + (gt * fac) * acc[m][n];
      }
    }
  }
}
template <class Epi>
__device__ __forceinline__ void gemm256_phase(const bf16_t* __restrict__ A, const bf16_t* __restrict__ Bt, int M, int N, int K, const Epi& epi) {
  using namespace g256;
  typedef __attribute__((address_space(3))) unsigned char lds_u8;
  lds_u8* shm8 = (lds_u8*)dyn_shm;
#define SA(b, h) (((b) * 2 + (h)) * (HT * 2))
#define SB(b, h) ((4 + (b) * 2 + (h)) * (HT * 2))
#define STAGE(bufoff, gbase, voff) do { _Pragma("unroll") for (int _i = 0; _i < 2; ++_i) \
      __builtin_amdgcn_global_load_lds((const unsigned*)((const char*)(gbase) + (voff)[_i]), (__attribute__((address_space(3))) unsigned*)(shm8 + (bufoff) + ldsw + _i * 8192), 16, 0, 0); } while (0)
#define LDA(dst, b, h) _Pragma("unroll") for (int m = 0; m < 4; ++m) _Pragma("unroll") for (int k = 0; k < 2; ++k) \
    dst[m][k] = *(const __attribute__((address_space(3))) bf16x8*)(shm8 + SA(b, h) + aoff + m * 2048 + k * 1024)
#define LDB(dst, b, h) _Pragma("unroll") for (int n = 0; n < 2; ++n) _Pragma("unroll") for (int k = 0; k < 2; ++k) \
    dst[n][k] = *(const __attribute__((address_space(3))) bf16x8*)(shm8 + SB(b, h) + boff + n * 2048 + k * 1024)
#define MMA(ai, bj, At_, Bt_) do { __builtin_amdgcn_s_setprio(1); \
    _Pragma("unroll") for (int m = 0; m < 4; ++m) _Pragma("unroll") for (int n = 0; n < 2; ++n) _Pragma("unroll") for (int k = 0; k < 2; ++k) \
      acc[ai][bj][m][n] = __builtin_amdgcn_mfma_f32_16x16x32_bf16(Bt_[n][k], At_[m][k], acc[ai][bj][m][n], 0, 0, 0); \
    __builtin_amdgcn_s_setprio(0); } while (0)
#define WAIT_V(n) asm volatile("s_waitcnt vmcnt(" #n ")" ::: "memory")
#define WAIT_L(n) asm volatile("s_waitcnt lgkmcnt(" #n ")" ::: "memory")
#define BAR __builtin_amdgcn_s_barrier()
#define SCHED __builtin_amdgcn_sched_barrier(0)
  int tid = threadIdx.x; asm volatile("" : "+v"(tid));
  const int wid = tid >> 6, lane = tid & 63, wr = wid >> 2, wc = wid & 3, fr = lane & 15, fq = lane >> 4;
  const int nM = M / BM, nN = N / BM, nwg = nM * nN, nt = K / BK;
  unsigned voff[2];
#pragma unroll
  for (int i = 0; i < 2; ++i) { int R, C; stage_rc(tid * 16 + i * 8192, R, C); voff[i] = (unsigned)(R * K + C) * 2u; }
  const unsigned ldsw = (unsigned)__builtin_amdgcn_readfirstlane(wid) * 1024u;
  const int aoff = lds_byte(wr * 64 + fr, fq * 8), boff = lds_byte(wc * 32 + fr, fq * 8);
  const size_t kstep = (size_t)BK * 2, hstep = (size_t)HALF * K * 2;
#define TILE_COORDS(T, BR, BC) do { int wgid = (T); \
    { int q = nwg / NXCD, r = nwg % NXCD, xcd = wgid % NXCD, off = wgid / NXCD; wgid = (xcd < r ? xcd * (q + 1) : r * (q + 1) + (xcd - r) * q) + off; } \
    const int nig = WGM * nN, gid = wgid / nig, fm = gid * WGM, gsz = (nM - fm) < WGM ? (nM - fm) : WGM; \
    BR = (fm + ((wgid % nig) % gsz)) * BM; BC = ((wgid % nig) / gsz) * BM; } while (0)
  int tile = blockIdx.x;
  if (tile < nwg) {
    int brow, bcol;
    TILE_COORDS(tile, brow, bcol);
    const char* cA = (const char*)A + (size_t)brow * K * 2; const char* cB = (const char*)Bt + (size_t)bcol * K * 2;
    WAIT_V(0); WAIT_L(0);
    __syncthreads();
    STAGE(SB(0, 0), cB, voff); STAGE(SA(0, 0), cA, voff);
    STAGE(SB(0, 1), cB + hstep, voff); STAGE(SA(0, 1), cA + hstep, voff);
  for (;;) {
    f32x4 acc[2][2][4][2];
#pragma unroll
    for (int a = 0; a < 2; ++a)
#pragma unroll
      for (int b = 0; b < 2; ++b)
#pragma unroll
        for (int m = 0; m < 4; ++m)
#pragma unroll
          for (int n = 0; n < 2; ++n) acc[a][b][m][n] = (f32x4){0.f, 0.f, 0.f, 0.f};
    bf16x8 At[4][2], B0[2][2], B1[2][2];
    if (wr == 1) BAR;
    WAIT_V(4); BAR;
    STAGE(SB(1, 0), cB + (size_t)(1) * kstep, voff); STAGE(SA(1, 0), cA + (size_t)(1) * kstep, voff); STAGE(SB(1, 1), cB + hstep + (size_t)(1) * kstep, voff);
    WAIT_V(6); BAR;
    for (int t = 0; t < nt - 2; t += 2) {
      LDB(B0, 0, 0); SCHED; LDA(At, 0, 0); STAGE(SA(1, 1), cA + hstep + (size_t)(t + 1) * kstep, voff);
      WAIT_L(8); BAR; WAIT_L(0); MMA(0, 0, At, B0); BAR; SCHED;
      LDB(B1, 0, 1); STAGE(SB(0, 0), cB + (size_t)(t + 2) * kstep, voff);
      BAR; WAIT_L(0); MMA(0, 1, At, B1); BAR;
      LDA(At, 0, 1); STAGE(SA(0, 0), cA + (size_t)(t + 2) * kstep, voff);
      BAR; WAIT_L(0); MMA(1, 0, At, B0); BAR; SCHED;
      STAGE(SB(0, 1), cB + hstep + (size_t)(t + 2) * kstep, voff);
      WAIT_V(6); BAR; MMA(1, 1, At, B1); BAR;
      LDB(B0, 1, 0); SCHED; LDA(At, 1, 0); STAGE(SA(0, 1), cA + hstep + (size_t)(t + 2) * kstep, voff);
      WAIT_L(8); BAR; WAIT_L(0); MMA(0, 0, At, B0); BAR; SCHED;
      LDB(B1, 1, 1); STAGE(SB(1, 0), cB + (size_t)(t + 3) * kstep, voff);
      BAR; WAIT_L(0); MMA(0, 1, At, B1); BAR;
      LDA(At, 1, 1); STAGE(SA(1, 0), cA + (size_t)(t + 3) * kstep, voff);
      BAR; WAIT_L(0); MMA(1, 0, At, B0); BAR; SCHED;
      STAGE(SB(1, 1), cB + hstep + (size_t)(t + 3) * kstep, voff);
      WAIT_V(6); BAR; MMA(1, 1, At, B1); BAR;
    }
    { LDB(B0, 0, 0); LDA(At, 0, 0); STAGE(SA(1, 1), cA + hstep + (size_t)(nt - 1) * kstep, voff);
      BAR; WAIT_L(0); MMA(0, 0, At, B0); BAR;
      LDB(B1, 0, 1); BAR; WAIT_L(0); MMA(0, 1, At, B1); BAR;
      LDA(At, 0, 1); WAIT_V(4); BAR; WAIT_L(0); MMA(1, 0, At, B0); MMA(1, 1, At, B1); BAR; }
    { LDB(B0, 1, 0); LDA(At, 1, 0); WAIT_V(2); BAR; WAIT_L(0); MMA(0, 0, At, B0); BAR;
      LDB(B1, 1, 1); WAIT_V(0); BAR; WAIT_L(0); MMA(0, 1, At, B1); BAR;
      LDA(At, 1, 1); BAR; WAIT_L(0); MMA(1, 0, At, B0); MMA(1, 1, At, B1); BAR; }
    if (wr == 0) BAR;
    const int ntile = tile + (int)gridDim.x; const bool more = ntile < nwg;
    int nbrow = 0, nbcol = 0;
    if (more) {
      TILE_COORDS(ntile, nbrow, nbcol);
      cA = (const char*)A + (size_t)nbrow * K * 2; cB = (const char*)Bt + (size_t)nbcol * K * 2;
      STAGE(SB(0, 0), cB, voff); STAGE(SA(0, 0), cA, voff);
      STAGE(SB(0, 1), cB + hstep, voff); STAGE(SA(0, 1), cA + hstep, voff);
    }
#pragma unroll
    for (int ai = 0; ai < 2; ++ai)
#pragma unroll
      for (int bj = 0; bj < 2; ++bj) epi(acc[ai][bj], brow + ai * HALF + wr * 64, bcol + bj * HALF + wc * 32, fr, fq);
    if (!more) break;
    tile = ntile; brow = nbrow; bcol = nbcol;
  }
  }
#undef TILE_COORDS
#undef SA
#undef SB
#undef STAGE
#undef LDA
#undef LDB
#undef MMA
#undef WAIT_V
#undef WAIT_L
#undef BAR
#undef SCHED
}

struct EpiGU256 { bf16_t* H;
  __device__ __forceinline__ void operator()(const f32x4 (&acc)[4][2], int row0, int col0, int fr, int fq) const {
    const int hb = col0 >> 1;
#pragma unroll
    for (int m = 0; m < 4; ++m) { const size_t row = row0 + m * 16 + fr; const f32x4 gt = acc[m][0], up = acc[m][1];
      *(s16x4*)(H + row * DFF + hb + 4 * fq) = pack4(siluf(gt[0]) * up[0], siluf(gt[1]) * up[1], siluf(gt[2]) * up[2], siluf(gt[3]) * up[3]); }
  } };
struct EpiResid256 { const float* srcL; const float* srcC; float* dstL; float* dstC; const float* mod; int gi; float fac;
  __device__ __forceinline__ void operator()(const f32x4 (&acc)[4][2], int row0, int col0, int fr, int fq) const {
#pragma unroll
    for (int m = 0; m < 4; ++m) { const int row = row0 + m * 16 + fr;
      const float* sp = row < NLAT ? srcL + (size_t)row * DM : srcC + (size_t)(row - NLAT) * DM;
      float* dp = row < NLAT ? dstL + (size_t)row * DM : dstC + (size_t)(row - NLAT) * DM;
      const float* mp = mod + (row < NLAT ? (row >> 12) : 8) * 9216 + gi * 1024;
#pragma unroll
      for (int n = 0; n < 2; ++n) { const int col = col0 + n * 16 + 4 * fq; const f32x4 gt = *(const f32x4*)(mp + col); const f32x4 sv = *(const f32x4*)(sp + col); *(f32x4*)(dp + col) = sv + (gt * fac) * acc[m][n]; } }
  } };
struct EpiInproj256 { bf16_t* U; bf16_t* QKVraw;
  __device__ __forceinline__ void operator()(const f32x4 (&acc)[4][2], int row0, int col0, int fr, int fq) const {
    bf16_t* base; int ld, cb;
    if (col0 < 512) { base = U; ld = UW; cb = col0; } else if (col0 < 1280) { base = QKVraw; ld = 768; cb = col0 - 512; } else { base = U; ld = UW; cb = col0 - 768; }
#pragma unroll
    for (int m = 0; m < 4; ++m) { const size_t row = row0 + m * 16 + fr;
#pragma unroll
      for (int n = 0; n < 2; ++n) *(s16x4*)(base + row * ld + cb + n * 16 + 4 * fq) = pack4(acc[m][n][0], acc[m][n][1], acc[m][n][2], acc[m][n][3]); }
  } };
__global__ void __launch_bounds__(512, 2) fwd_megakernel(Params p) {
  cg::grid_group grid = cg::this_grid();
  unsigned char* lds = (unsigned char*)dyn_shm + __builtin_amdgcn_readfirstlane((int)(raw_tid() >> 8)) * 65536;
  __shared__ int s_item;
  __shared__ u32x4 xb_words;
  if (raw_tid() == 0) xb_words = (u32x4){0u, 0u, 0u, 0u};
  __syncthreads();
  const XcdBarrier xb = xcd_barrier_post(p.bar, (volatile LAS unsigned*)&xb_words);
  mod_partial(p, (float*)lds);
  conv_weights(p, 0, (float*)lds);
  grid.sync();
  mod_final(p);
  xcd_barrier(xb);
  for (int layer = 0; layer < 2; ++layer) {
    const bool need_ctx = layer == 0;
    const float* mod = p.MOD + layer * 82944;
    const float* srcL = layer == 0 ? p.x : p.out; const float* srcC = layer == 0 ? p.ctx : p.Xc;
    if (layer == 1) conv_weights(p, 1, (float*)lds);
    norm_phase<0>(srcL, srcC, NTOK, p.norm1_g + layer * DM, mod, 0, 1, p.XN, nullptr);
    xcd_barrier(xb);
    gemm256_phase(p.XN, p.W + OW_GU1, NTOK, 2 * DFF, DM, EpiGU256{p.H});
    xcd_barrier(xb);
    gemm256_phase(p.H, p.W + OW_D1, NLAT, DM, DFF, EpiResid256{srcL, srcC, p.out, p.Xc, mod, 2, 0.5f});
    gemm64_ctx(p.H + (size_t)NLAT * DFF, DFF, p.W + OW_D1, DFF, DFF, srcC, p.Xc, mod, 2, 0.5f, lds);
    xcd_barrier(xb);
    norm_phase<0>(p.out, p.Xc, NTOK, p.norm2_g + layer * DM, mod, 3, 4, p.XN, nullptr);
    xcd_barrier(xb);
    gemm256_phase(p.XN, p.W + OW_IN, NTOK, 2816, DM, EpiInproj256{p.U, p.QKVraw});
    xcd_barrier(xb);
    prep_phase(p, layer);
    xcd_barrier(xb);
    gemm_phase(p.U + 784, UW, p.W + OW_UQ, 256, NTOK, 384, 256, EpiPlain{p.QM, 384}, lds);
    gemm_phase(p.U + 1040, UW, p.W + OW_UKV, 128, NTOK, 512, 128, EpiKVM{p.KVM, p.kmx + layer * 32}, lds);
    dn_chunk(p, lds);
    xcd_barrier(xb);
    mixer_phase(p, layer, need_ctx, lds, &s_item);
    xcd_barrier(xb);
    const int M2 = need_ctx ? NTOK : NLAT;
    gated_out(p, layer, M2);
    xcd_barrier(xb);
    gemm256_phase(p.XN, p.W + OW_OUT, NLAT, DM, DM, EpiResid256{p.out, p.Xc, p.out, p.Xc, mod, 5, 1.0f});
    if (need_ctx) gemm64_ctx(p.XN + (size_t)NLAT * DM, DM, p.W + OW_OUT, DM, DM, p.Xc, p.Xc, mod, 5, 1.0f, lds);
    xcd_barrier(xb);
    norm_phase<0>(p.out, p.Xc, M2, p.norm3_g + layer * DM, mod, 6, 7, p.XN, nullptr);
    xcd_barrier(xb);
    gemm256_phase(p.XN, p.W + OW_GU2, M2, 2 * DFF, DM, EpiGU256{p.H});
    xcd_barrier(xb);
    gemm256_phase(p.H, p.W + OW_D2, NLAT, DM, DFF, EpiResid256{p.out, p.Xc, p.out, p.Xc, mod, 8, 0.5f});
    if (need_ctx) gemm64_ctx(p.H + (size_t)NLAT * DFF, DFF, p.W + OW_D2, DFF, DFF, p.Xc, p.Xc, mod, 8, 0.5f, lds);
    xcd_barrier(xb);
  }
  norm_phase<1>(p.out, p.Xc, NLAT, p.final_norm_g, nullptr, 0, 0, nullptr, p.out);
}

extern "C" void kernel_launch(void* const* d_in, const int* in_sizes, int n_in, void* d_out, int out_size, void* d_ws, size_t ws_size, hipStream_t stream) {
  static int grid_blocks = 0;
  if (!grid_blocks) {
    int dev = 0, cus = 0, per_cu = 0;
    hipGetDevice(&dev);
    hipDeviceGetAttribute(&cus, hipDeviceAttributeMultiprocessorCount, dev);
    hipFuncSetAttribute((const void*)fwd_megakernel, hipFuncAttributeMaxDynamicSharedMemorySize, 131072);
    hipOccupancyMaxActiveBlocksPerMultiprocessor(&per_cu, fwd_megakernel, 512, 131072);
    if (per_cu > 1) per_cu = 1;
    if (per_cu < 1) per_cu = 1;
    grid_blocks = cus * per_cu;
  }
  Params p; memset(&p, 0, sizeof(p));
  const float** pin = (const float**)&p;
  for (int i = 0; i < 28; ++i) pin[i] = (const float*)d_in[i];
  p.out = (float*)d_out;
  unsigned char* ws = (unsigned char*)d_ws; size_t off = 0;
  auto take = [&](size_t bytes) { unsigned char* q = ws + off; off += (bytes + 255) & ~(size_t)255; return q; };
  p.Xc = (float*)take((size_t)NCTX * DM * 4);
  p.XN = (bf16_t*)take((size_t)NTOK * DM * 2);
  p.W = (bf16_t*)take((size_t)W_ELEMS * 2);
  p.MOD = (float*)take((size_t)165888 * 4);
  p.bar = (unsigned*)take(16384);
  p.cnt = p.bar + 3584;
  p.kmx = p.bar + 3584 + 128;
  unsigned char* big = ws + off;
  p.H = (bf16_t*)big;
  p.PART = (float*)big;
  size_t boff = 0;
  auto takeb = [&](size_t bytes) { unsigned char* q = big + boff; boff += (bytes + 255) & ~(size_t)255; return q; };
  p.U = (bf16_t*)takeb((size_t)NTOK * UW * 2);
  p.QM = (bf16_t*)takeb((size_t)NTOK * 384 * 2);
  p.KVM = (bf16_t*)takeb((size_t)NTOK * 512 * 2);
  p.QKVd = (bf16_t*)takeb((size_t)NTOK * 768 * 2);
  p.DNW = (bf16_t*)takeb((size_t)4352 * 4096 * 2);
  p.QKVraw = p.DNW;
  p.DNU = (bf16_t*)takeb((size_t)4352 * 4096 * 2);
  p.DNI = (bf16_t*)takeb((size_t)4352 * 4096 * 2);
  p.DGC = (float*)takeb((size_t)4352 * 64 * 4);
  p.OF = (bf16_t*)takeb((size_t)NTOK * 256 * 2);
  p.OB = (bf16_t*)takeb((size_t)NTOK * 256 * 2);
  p.GB = (float*)takeb((size_t)NTOK * 16 * 4);
  size_t hbytes = (size_t)NTOK * DFF * 2;
  size_t need = off + (boff > hbytes ? boff : hbytes);
  if (need > ws_size) { fprintf(stderr, "workspace too small: need %zu have %zu\n", need, ws_size); return; }
  hipMemsetAsync(p.bar, 0, 16384, stream);
  void* args[] = {&p};
  hipError_t e = hipLaunchCooperativeKernel((void*)fwd_megakernel, dim3(grid_blocks), dim3(512), args, 131072, stream);
  if (e != hipSuccess) fprintf(stderr, "cooperative launch failed: %s (grid %d)\n", hipGetErrorString(e), grid_blocks);
}
```
